# Optimizing an MI355X kernel written in HIP

```python
import jax, jax.numpy as jnp
from jax import lax
import numpy as np

D_MODEL = 2048
BATCH = 4
SEQ = 4096
DEPTH = 2

CTX_LEN = 256
GRID_W = 64
D_MIX = D_MODEL
N_GROUPS = 4
GROUP_W = D_MIX // N_GROUPS
CONV_W = GROUP_W
CONV_K = 3
SWA_HEAD_DIM = 64
SWA_HEADS = GROUP_W // SWA_HEAD_DIM
SWA_KV_HEADS = 2
SWA_WINDOW = 128
SWA_BLOCK = 128
FNET_HEAD_DIM = 64
FNET_HEADS = GROUP_W // FNET_HEAD_DIM
MLA_HEADS = 8
MLA_NOPE = 64
MLA_ROPE = 32
MLA_V = GROUP_W // MLA_HEADS
MLA_Q_LORA = 512
MLA_KV_LORA = 256
MLA_BLOCK = 128
N_EXPERTS = 16
EXPERT_FF = 2048
EC_CAPACITY = 2
ROPE_THETA = 10000.0
EPS = 1e-6

IN_SIZES = (CONV_W, CONV_W, CONV_W,
            SWA_HEADS * SWA_HEAD_DIM, SWA_KV_HEADS * SWA_HEAD_DIM, SWA_KV_HEADS * SWA_HEAD_DIM,
            GROUP_W,
            MLA_Q_LORA, MLA_KV_LORA, MLA_ROPE)
IN_COLS = 3 * CONV_W + (SWA_HEADS + 2 * SWA_KV_HEADS) * SWA_HEAD_DIM + GROUP_W + MLA_Q_LORA + MLA_KV_LORA + MLA_ROPE

kernel_name = "hybrid_parallel_groups_ec_moe_diffusion"


def rmsnorm(x, g):
    xf = x.astype(jnp.float32)
    y = xf * lax.rsqrt(jnp.mean(xf * xf, axis=-1, keepdims=True) + EPS)
    return (y * g.astype(jnp.float32)).astype(x.dtype)


def group_rmsnorm(y, g):
    shp = y.shape
    out = rmsnorm(y.reshape(shp[:-1] + (N_GROUPS, GROUP_W)), g.reshape(N_GROUPS, GROUP_W))
    return out.reshape(shp)


def modulate(h, shift, scale):
    return h * (1.0 + scale) + shift


def axial_rope_tables(rows_n, rot_dim):
    rows = jnp.broadcast_to(jnp.arange(rows_n, dtype=jnp.float32)[:, None], (rows_n, GRID_W)).reshape(-1)
    cols = jnp.broadcast_to(jnp.arange(GRID_W, dtype=jnp.float32)[None, :], (rows_n, GRID_W)).reshape(-1)
    n_freq = rot_dim // 4
    inv_freq = ROPE_THETA ** (-jnp.arange(n_freq, dtype=jnp.float32) / n_freq)
    ang = jnp.concatenate([rows[:, None] * inv_freq, cols[:, None] * inv_freq], axis=-1)
    return jnp.cos(ang), jnp.sin(ang)


def apply_rope(x, cos, sin):
    half = x.shape[-1] // 2
    cs = cos[None, :, None, :].astype(x.dtype)
    sn = sin[None, :, None, :].astype(x.dtype)
    x1, x2 = x[..., :half], x[..., half:]
    return jnp.concatenate([x1 * cs - x2 * sn, x2 * cs + x1 * sn], axis=-1)


def mixer_inputs(h, w_in, q_norm_g, w_uq, kv_norm_g, w_ukv, rope):
    B, N, _ = h.shape
    p = h @ w_in
    parts, start = [], 0
    for width in IN_SIZES:
        parts.append(p[..., start:start + width])
        start += width
    cb, cc, ch, sq, sk, sv, fu, mcq, mckv, mkpe = parts
    sq = sq.reshape(B, N, SWA_HEADS, SWA_HEAD_DIM)
    sk = sk.reshape(B, N, SWA_KV_HEADS, SWA_HEAD_DIM)
    sv = sv.reshape(B, N, SWA_KV_HEADS, SWA_HEAD_DIM)
    q = (rmsnorm(mcq, q_norm_g) @ w_uq).reshape(B, N, MLA_HEADS, MLA_NOPE + MLA_ROPE)
    kv = (rmsnorm(mckv, kv_norm_g) @ w_ukv).reshape(B, N, MLA_HEADS, MLA_NOPE + MLA_V)
    q_nope, q_pe = q[..., :MLA_NOPE], q[..., MLA_NOPE:]
    k_nope, mv = kv[..., :MLA_NOPE], kv[..., MLA_NOPE:]
    k_pe = mkpe[:, :, None, :]
    if rope is not None:
        cos_s, sin_s, cos_m, sin_m = rope
        sq = apply_rope(sq, cos_s, sin_s)
        sk = apply_rope(sk, cos_s, sin_s)
        q_pe = apply_rope(q_pe, cos_m, sin_m)
        k_pe = apply_rope(k_pe, cos_m, sin_m)
    mq = jnp.concatenate([q_nope, q_pe], axis=-1)
    mk = jnp.concatenate([k_nope, jnp.broadcast_to(k_pe, (B, N, MLA_HEADS, MLA_ROPE))], axis=-1)
    return cb, cc, ch, sq, sk, sv, fu, mq, mk, mv


def short_conv_mixer(gate_b, gate_c, h, w):
    u = gate_c * h
    up = jnp.pad(u, ((0, 0), (1, 1), (0, 0)))
    y = up[:, :-2] * w[0] + up[:, 1:-1] * w[1] + up[:, 2:] * w[2]
    return gate_b * y


def fourier_mixer(u):
    B, N, _ = u.shape
    uh = u.reshape(B, N, FNET_HEADS, FNET_HEAD_DIM).astype(jnp.float32)
    y = jnp.fft.fft2(uh, axes=(1, 3), norm="ortho").real
    return y.reshape(B, N, GROUP_W).astype(u.dtype)


def swa_latent(q, k, v, kc, vc, sink):
    B, N, Hq, d = q.shape
    Hkv = k.shape[2]
    G = Hq // Hkv
    T = SWA_BLOCK
    nb = N // T
    scale = d ** -0.5
    qb = q.reshape(B, nb, T, Hkv, G, d)

    def band(t):
        tp = jnp.pad(t, ((0, 0), (T, T), (0, 0), (0, 0))).reshape(B, nb + 2, T, Hkv, d)
        return jnp.concatenate([tp[:, :-2], tp[:, 1:-1], tp[:, 2:]], axis=2)

    kb, vb = band(k), band(v)
    s_loc = jnp.einsum('bnqhgd,bnkhd->bnhgqk', qb, kb, preferred_element_type=jnp.float32) * scale
    qpos = jnp.arange(nb)[:, None] * T + jnp.arange(T)[None, :]
    kpos = jnp.arange(nb)[:, None] * T - T + jnp.arange(3 * T)[None, :]
    rel = kpos[:, None, :] - qpos[:, :, None]
    valid = (jnp.abs(rel) <= SWA_WINDOW) & (kpos[:, None, :] >= 0) & (kpos[:, None, :] < N)
    s_loc = jnp.where(valid[None, :, None, None], s_loc, -1e30)
    s_ctx = jnp.einsum('bnqhgd,blhd->bnhgql', qb, kc, preferred_element_type=jnp.float32) * scale
    s_sink = jnp.broadcast_to(sink.astype(jnp.float32).reshape(1, 1, Hkv, G, 1, 1), s_loc.shape[:-1] + (1,))
    p = jax.nn.softmax(jnp.concatenate([s_loc, s_ctx, s_sink], axis=-1), axis=-1)
    p_loc = p[..., :3 * T].astype(v.dtype)
    p_ctx = p[..., 3 * T:3 * T + kc.shape[1]].astype(v.dtype)
    o = (jnp.einsum('bnhgqk,bnkhd->bnqhgd', p_loc, vb)
         + jnp.einsum('bnhgql,blhd->bnqhgd', p_ctx, vc))
    return o.reshape(B, N, Hq * d)


def swa_context(q, k, v, sink):
    B, L, Hq, d = q.shape
    Hkv = k.shape[2]
    G = Hq // Hkv
    qg = q.reshape(B, L, Hkv, G, d)
    s = jnp.einsum('blhgd,bmhd->bhglm', qg, k, preferred_element_type=jnp.float32) * (d ** -0.5)
    s_sink = jnp.broadcast_to(sink.astype(jnp.float32).reshape(1, Hkv, G, 1, 1), (B, Hkv, G, L, 1))
    p = jax.nn.softmax(jnp.concatenate([s, s_sink], axis=-1), axis=-1)[..., :L].astype(v.dtype)
    o = jnp.einsum('bhglm,bmhd->blhgd', p, v)
    return o.reshape(B, L, Hq * d)


def mla_latent(q, k, v, kc, vc):
    B, N, H, dq = q.shape
    nb = N // MLA_BLOCK
    scale = dq ** -0.5
    qb = q.reshape(B, nb, MLA_BLOCK, H, dq).transpose(1, 0, 2, 3, 4)

    def block(qi):
        s_lat = jnp.einsum('bqhd,bkhd->bhqk', qi, k, preferred_element_type=jnp.float32) * scale
        s_ctx = jnp.einsum('bqhd,blhd->bhql', qi, kc, preferred_element_type=jnp.float32) * scale
        p = jax.nn.softmax(jnp.concatenate([s_lat, s_ctx], axis=-1), axis=-1).astype(v.dtype)
        return (jnp.einsum('bhqk,bkhd->bqhd', p[..., :N], v)
                + jnp.einsum('bhql,blhd->bqhd', p[..., N:], vc))

    o = lax.map(block, qb)
    return o.transpose(1, 0, 2, 3, 4).reshape(B, N, H * v.shape[-1])


def mla_context(q, k, v):
    B, L, H, dq = q.shape
    s = jnp.einsum('blhd,bmhd->bhlm', q, k, preferred_element_type=jnp.float32) * (dq ** -0.5)
    p = jax.nn.softmax(s, axis=-1).astype(v.dtype)
    return jnp.einsum('bhlm,bmhd->blhd', p, v).reshape(B, L, H * v.shape[-1])


def mix_latent(px, pc, conv_w, sink):
    cb, cc, ch, sq, sk, sv, fu, mq, mk, mv = px
    skc, svc, mkc, mvc = pc[4], pc[5], pc[8], pc[9]
    return jnp.concatenate([
        short_conv_mixer(cb, cc, ch, conv_w),
        swa_latent(sq, sk, sv, skc, svc, sink),
        fourier_mixer(fu),
        mla_latent(mq, mk, mv, mkc, mvc),
    ], axis=-1)


def mix_context(pc, conv_w, sink):
    cb, cc, ch, sq, sk, sv, fu, mq, mk, mv = pc
    return jnp.concatenate([
        short_conv_mixer(cb, cc, ch, conv_w),
        swa_context(sq, sk, sv, sink),
        fourier_mixer(fu),
        mla_context(mq, mk, mv),
    ], axis=-1)


def expert_choice_ffn(h, w_router, w_gate, w_up, w_down):
    B, N, D = h.shape
    cap = EC_CAPACITY * N // N_EXPERTS
    aff = jax.nn.softmax(jnp.einsum('bnd,de->bne', h, w_router, preferred_element_type=jnp.float32), axis=-1)
    g, idx = lax.top_k(jnp.swapaxes(aff, 1, 2), cap)
    xs = jax.vmap(lambda hb, ib: hb[ib])(h, idx)
    a = jnp.einsum('becd,edf->becf', xs, w_gate)
    u = jnp.einsum('becd,edf->becf', xs, w_up)
    y = jnp.einsum('becf,efd->becd', jax.nn.silu(a) * u, w_down)
    y = y * g[..., None].astype(y.dtype)
    return jax.vmap(lambda ib, yb: jnp.zeros((N, D), yb.dtype).at[ib.reshape(-1)].add(yb.reshape(-1, D)))(idx, y)


def setup_inputs(seed: int = 0) -> dict:
    key = jax.random.key(seed)
    ks = jax.random.split(key, 24)
    f32 = jnp.float32

    def nrm(k, shape, fan_in):
        return jax.random.normal(k, shape, f32) * (fan_in ** -0.5)

    def gain(k, shape):
        return 1.0 + 0.02 * jax.random.normal(k, shape, f32)

    return {
        "x": jax.random.normal(ks[0], (BATCH, SEQ, D_MODEL), f32),
        "c": jax.random.normal(ks[1], (BATCH, D_MODEL), f32),
        "ctx": jax.random.normal(ks[2], (BATCH, CTX_LEN, D_MODEL), f32),
        "c_ctx": jax.random.normal(ks[3], (D_MODEL,), f32),
        "ada_w": nrm(ks[4], (DEPTH, D_MODEL, 6 * D_MODEL), D_MODEL),
        "ada_b": 0.01 * jax.random.normal(ks[5], (DEPTH, 6 * D_MODEL), f32),
        "norm1_g": gain(ks[6], (DEPTH, D_MODEL)),
        "norm2_g": gain(ks[7], (DEPTH, D_MODEL)),
        "w_in": nrm(ks[8], (DEPTH, D_MODEL, IN_COLS), D_MODEL),
        "conv_w": nrm(ks[9], (DEPTH, CONV_K, CONV_W), CONV_K),
        "swa_sink": 0.5 * jax.random.normal(ks[10], (DEPTH, SWA_HEADS), f32),
        "mla_q_norm_g": gain(ks[11], (DEPTH, MLA_Q_LORA)),
        "mla_w_uq": nrm(ks[12], (DEPTH, MLA_Q_LORA, MLA_HEADS * (MLA_NOPE + MLA_ROPE)), MLA_Q_LORA),
        "mla_kv_norm_g": gain(ks[13], (DEPTH, MLA_KV_LORA)),
        "mla_w_ukv": nrm(ks[14], (DEPTH, MLA_KV_LORA, MLA_HEADS * (MLA_NOPE + MLA_V)), MLA_KV_LORA),
        "out_norm_g": gain(ks[15], (DEPTH, D_MIX)),
        "w_out": nrm(ks[16], (DEPTH, D_MIX, D_MODEL), D_MIX),
        "w_router": nrm(ks[17], (DEPTH, D_MODEL, N_EXPERTS), D_MODEL),
        "w_gate": nrm(ks[18], (DEPTH, N_EXPERTS, D_MODEL, EXPERT_FF), D_MODEL),
        "w_up": nrm(ks[19], (DEPTH, N_EXPERTS, D_MODEL, EXPERT_FF), D_MODEL),
        "w_down": nrm(ks[20], (DEPTH, N_EXPERTS, EXPERT_FF, D_MODEL), EXPERT_FF),
        "final_norm_g": gain(ks[21], (D_MODEL,)),
    }


def reference(x, c, ctx, c_ctx, ada_w, ada_b, norm1_g, norm2_g, w_in, conv_w, swa_sink,
              mla_q_norm_g, mla_w_uq, mla_kv_norm_g, mla_w_ukv, out_norm_g, w_out,
              w_router, w_gate, w_up, w_down, final_norm_g):
    n_tok = x.shape[1]
    ROWS = n_tok // GRID_W
    cos_s, sin_s = axial_rope_tables(ROWS, SWA_HEAD_DIM)
    cos_m, sin_m = axial_rope_tables(ROWS, MLA_ROPE)
    rope = (cos_s, sin_s, cos_m, sin_m)
    for layer in range(DEPTH):
        last = layer == DEPTH - 1
        mx = jnp.split(jax.nn.silu(c) @ ada_w[layer] + ada_b[layer], 6, axis=-1)
        sh1, sc1, g1, sh2, sc2, g2 = [m[:, None, :] for m in mx]
        csh1, csc1, cg1, csh2, csc2, cg2 = jnp.split(
            jax.nn.silu(c_ctx) @ ada_w[layer] + ada_b[layer], 6, axis=-1)

        hx = modulate(rmsnorm(x, norm1_g[layer]), sh1, sc1)
        hc = modulate(rmsnorm(ctx, norm1_g[layer]), csh1, csc1)
        px = mixer_inputs(hx, w_in[layer], mla_q_norm_g[layer], mla_w_uq[layer],
                          mla_kv_norm_g[layer], mla_w_ukv[layer], rope)
        pc = mixer_inputs(hc, w_in[layer], mla_q_norm_g[layer], mla_w_uq[layer],
                          mla_kv_norm_g[layer], mla_w_ukv[layer], None)
        yx = mix_latent(px, pc, conv_w[layer], swa_sink[layer])
        x = x + g1 * (group_rmsnorm(yx, out_norm_g[layer]) @ w_out[layer])
        if not last:
            yc = mix_context(pc, conv_w[layer], swa_sink[layer])
            ctx = ctx + cg1 * (group_rmsnorm(yc, out_norm_g[layer]) @ w_out[layer])

        fx = modulate(rmsnorm(x, norm2_g[layer]), sh2, sc2)
        x = x + g2 * expert_choice_ffn(fx, w_router[layer], w_gate[layer], w_up[layer], w_down[layer])
        if not last:
            fc = modulate(rmsnorm(ctx, norm2_g[layer]), csh2, csc2)
            ctx = ctx + cg2 * expert_choice_ffn(fc, w_router[layer], w_gate[layer], w_up[layer], w_down[layer])
    return rmsnorm(x, final_norm_g)
```

```cpp
#include <hip/hip_runtime.h>
#include <cstdio>
#include <cstdint>

#define GAS __attribute__((address_space(1)))
#define LAS __attribute__((address_space(3)))
typedef unsigned short bf16;
typedef unsigned u32x4 __attribute__((ext_vector_type(4)));
typedef unsigned u32x2 __attribute__((ext_vector_type(2)));
typedef float f32x4 __attribute__((ext_vector_type(4)));
typedef float f32x2 __attribute__((ext_vector_type(2)));
typedef float f32x16 __attribute__((ext_vector_type(16)));
typedef short bf16x8 __attribute__((ext_vector_type(8)));
typedef short s16x4 __attribute__((ext_vector_type(4)));
typedef __bf16 bf16x2_t __attribute__((ext_vector_type(2)));

constexpr int D = 2048, NB = 4, SEQ = 4096, CTXL = 256;
constexpr int TL = NB * SEQ, TC = NB * CTXL, T = TL + TC;
constexpr int INC = 3616, NE = 16, FF = 2048, CAPL = 512, CAPC = 32;
constexpr int KVR = SEQ + CTXL;
constexpr int EROWS = 2304;
constexpr float EPS = 1e-6f;
constexpr float LOG2E = 1.4426950408889634f;
constexpr float QSC_S = 0.125f * LOG2E;
constexpr float QSC_M = 0.10206207261596575f * LOG2E;
constexpr int NWAVES = 8, NTHR = 512;

__device__ __forceinline__ unsigned cvtpk(float lo, float hi) { f32x2 v = {lo, hi}; bf16x2_t b = __builtin_convertvector(v, bf16x2_t); return __builtin_bit_cast(unsigned, b); }
__device__ __forceinline__ float bf_lo(unsigned w) { return __uint_as_float(w << 16); }
__device__ __forceinline__ float bf_hi(unsigned w) { return __uint_as_float(w & 0xffff0000u); }
__device__ __forceinline__ float wave_sum(float v) {
#pragma unroll
    for (int o = 1; o < 64; o <<= 1) v += __shfl_xor(v, o);
    return v;
}
__device__ __forceinline__ float silu_f(float v) { return v / (1.0f + __expf(-v)); }
__device__ __forceinline__ int mod_row(int t) { return t < TL ? (t >> 12) : 4; }
__device__ __forceinline__ int kv_row(int t) { return t < TL ? (t >> 12) * KVR + (t & (SEQ - 1)) : ((t - TL) >> 8) * KVR + SEQ + ((t - TL) & (CTXL - 1)); }

#define XB_TMO      128
#define XB_XCNT(j)  (256  + 64 * (j))
#define XB_XSUB(j)  (1280 + 64 * (j))
#define XB_XGEN(j)  (2304 + 64 * (j))
#define XB_TOP      3328
#define XB_TOPGEN   3392
#define XCD_BAR_WORDS 3456
#define XB_SPIN_CAP (1u << 18)
__device__ __forceinline__ unsigned xb_ld(unsigned* p)              { return __hip_atomic_load(p, __ATOMIC_RELAXED, __HIP_MEMORY_SCOPE_AGENT); }
__device__ __forceinline__ unsigned xb_add(unsigned* p, unsigned v) { return __hip_atomic_fetch_add(p, v, __ATOMIC_RELAXED, __HIP_MEMORY_SCOPE_AGENT); }
__device__ __forceinline__ unsigned xb_xcc_id() { return (unsigned)__builtin_amdgcn_s_getreg((3 << 11) | 20) & 0xFu; }
#define XB_SPIN(cond, bar) do { unsigned _sp = 0; while (cond) { __builtin_amdgcn_s_sleep(1); \
    if ((++_sp & 255u) == 0u) { if (xb_ld(&(bar)[XB_TMO])) break; if (_sp > XB_SPIN_CAP) { atomicAdd(&(bar)[XB_TMO], 1u); break; } } } } while (0)
struct XcdBarrier { unsigned* bar; unsigned x; volatile LAS unsigned* st; };
__device__ __forceinline__ XcdBarrier xcd_barrier_post(unsigned* bar, volatile LAS unsigned* st) {
    XcdBarrier b; b.bar = bar; b.x = xb_xcc_id(); b.st = st;
    if (threadIdx.x == 0) (void)xb_add(&bar[XB_XCNT(b.x)], 1u);
    return b;
}
__device__ __forceinline__ void xcd_barrier_complete(unsigned* bar, unsigned x, unsigned& nloc, unsigned& nx) {
    const unsigned G = gridDim.x * gridDim.y * gridDim.z;
    unsigned sum, cnt, mine, sp = 0u;
    for (;;) {
        sum = 0u; cnt = 0u; mine = 0u;
#pragma unroll
        for (unsigned j = 0; j < 16; ++j) { const unsigned c = xb_ld(&bar[XB_XCNT(j)]); sum += c; cnt += (c > 0u) ? 1u : 0u; mine = (j == x) ? c : mine; }
        if (sum == G) break;
        __builtin_amdgcn_s_sleep(1);
        if ((++sp & 255u) == 0u) { if (xb_ld(&bar[XB_TMO])) break; if (sp > XB_SPIN_CAP) { atomicAdd(&bar[XB_TMO], 1u); break; } }
    }
    nloc = mine > 0u ? mine : 1u; nx = cnt > 0u ? cnt : 1u;
}
__device__ __forceinline__ void xcd_barrier(const XcdBarrier& b) {
    asm volatile("s_waitcnt vmcnt(0)" ::: "memory");
    __syncthreads();
    if (threadIdx.x == 0) {
        unsigned* bar = b.bar;
        __builtin_amdgcn_s_waitcnt(0);
        unsigned nloc = b.st[0], nx = b.st[1];
        if (nloc == 0u) { xcd_barrier_complete(bar, b.x, nloc, nx); b.st[0] = nloc; b.st[1] = nx; }
        const unsigned old = xb_add(&bar[XB_XSUB(b.x)], 1u);
        const unsigned gen = old / nloc;
        if (old + 1u == (gen + 1u) * nloc) {
            __builtin_amdgcn_fence(__ATOMIC_RELEASE, "agent");
            asm volatile("s_waitcnt vmcnt(0)" ::: "memory");
            const unsigned og = xb_add(&bar[XB_TOP], 1u);
            const unsigned tg = og / nx;
            if (og + 1u == (tg + 1u) * nx) xb_add(&bar[XB_TOPGEN], 1u);
            else XB_SPIN(xb_ld(&bar[XB_TOPGEN]) == tg, bar);
            __builtin_amdgcn_fence(__ATOMIC_ACQUIRE, "agent");
            xb_add(&bar[XB_XGEN(b.x)], 1u);
            asm volatile("s_waitcnt vmcnt(0)" ::: "memory");
        } else {
            XB_SPIN(xb_ld(&bar[XB_XGEN(b.x)]) == gen, bar);
            __builtin_amdgcn_fence(__ATOMIC_ACQUIRE, "agent");
            asm volatile("s_waitcnt vmcnt(0)" ::: "memory");
        }
    }
    __syncthreads();
}

namespace pg8 {
constexpr int BM = 256, BK = 64, HALF = 128, HTB = HALF * BK * 2, STAGE_BYTES = 8 * HTB;
__device__ __forceinline__ int lds_byte(int r, int c) { const int st = (r >> 4) * 2 + (c >> 5), rr = r & 15, cc = c & 31, ob = rr * 64 + cc * 2; return st * 1024 + (ob ^ (((ob >> 9) & 1) << 5)); }
__device__ __forceinline__ void stage_rc(int b, int& R, int& C) { const int st = b / 1024, sb = b % 1024, swz = sb ^ (((sb >> 9) & 1) << 5); R = (st >> 1) * 16 + swz / 64; C = (st & 1) * 32 + (swz % 64) / 2; }
__device__ __forceinline__ int perm32(int rho) { const int n = rho >> 4, i = rho & 15; return 8 * (i >> 2) + 4 * n + (i & 3); }

struct Unit { const char* a; const char* b; int pm, pn, kind, aux; };

template <bool GATHER, class Epi, class Sched>
__device__ __forceinline__ void gemm_phase(LAS unsigned char* lds, const int K, const unsigned lda, const unsigned ldb, const Sched& S, const Epi& E) {
    int tid_ = threadIdx.x; asm volatile("" : "+v"(tid_));
    const int tid = tid_, wid = __builtin_amdgcn_readfirstlane(tid >> 6), lane = tid & 63, wr = wid >> 2, wc = wid & 3, fr = lane & 15, fq = lane >> 4;
    const int nt = K / BK;
    int Rr[2], Cc[2]; unsigned voffB[2];
#pragma unroll
    for (int i = 0; i < 2; ++i) { stage_rc(tid * 16 + i * 8192, Rr[i], Cc[i]); const int Rb = (Rr[i] & ~31) + perm32(Rr[i] & 31); voffB[i] = (unsigned)Rb * ldb + (unsigned)Cc[i] * 2u; }
    const size_t kstep = (size_t)(BK * 2);
    const size_t hstepB = (size_t)HALF * ldb;
    const unsigned ldsw = (unsigned)wid * 1024u;
    const int aoff = lds_byte(wr * 64 + fr, fq * 8), boff = lds_byte(wc * 32 + fr, fq * 8);
#define PG8_SA(b, h) (((b) * 2 + (h)) * HTB)
#define PG8_SB(b, h) ((4 + (b) * 2 + (h)) * HTB)
#define PG8_STAGE(bufoff, gbase, voff) do { _Pragma("unroll") for (int _i = 0; _i < 2; ++_i) \
        __builtin_amdgcn_global_load_lds((const unsigned*)((const char*)(gbase) + (voff)[_i]), (LAS unsigned*)(lds + (bufoff) + ldsw + _i * 8192), 16, 0, 0); } while (0)
#define PG8_LDA(dst, b, h) do { _Pragma("unroll") for (int m = 0; m < 4; ++m) _Pragma("unroll") for (int k = 0; k < 2; ++k) dst[m][k] = *(const LAS bf16x8*)(lds + PG8_SA(b, h) + aoff + m * 2048 + k * 1024); } while (0)
#define PG8_LDB(dst, b, h) do { _Pragma("unroll") for (int n = 0; n < 2; ++n) _Pragma("unroll") for (int k = 0; k < 2; ++k) dst[n][k] = *(const LAS bf16x8*)(lds + PG8_SB(b, h) + boff + n * 2048 + k * 1024); } while (0)
#define PG8_MMA(ai, bj, At, Bt) do { __builtin_amdgcn_s_setprio(1); _Pragma("unroll") for (int m = 0; m < 4; ++m) _Pragma("unroll") for (int n = 0; n < 2; ++n) _Pragma("unroll") for (int k = 0; k < 2; ++k) \
        acc[ai][bj][m][n] = __builtin_amdgcn_mfma_f32_16x16x32_bf16(Bt[n][k], At[m][k], acc[ai][bj][m][n], 0, 0, 0); __builtin_amdgcn_s_setprio(0); } while (0)
#define PG8_WAIT_V(n) asm volatile("s_waitcnt vmcnt(" #n ")" ::: "memory")
#define PG8_WAIT_L(n) asm volatile("s_waitcnt lgkmcnt(" #n ")" ::: "memory")
#define PG8_BAR __builtin_amdgcn_s_barrier()
#define PG8_SCHED __builtin_amdgcn_sched_barrier(0)
#define PG8_OFFS(dst, ui_) do { _Pragma("unroll") for (int _h = 0; _h < 2; ++_h) _Pragma("unroll") for (int _i = 0; _i < 2; ++_i) \
        dst[_h][_i] = (GATHER ? S.rowoff((ui_), _h * HALF + Rr[_i]) : (unsigned)(_h * HALF + Rr[_i]) * lda) + (unsigned)Cc[_i] * 2u; } while (0)
    Unit cur, nxt; int ui = 0;
    if (!S.next(0, cur)) return;
    f32x4 acc[2][2][4][2];
#pragma unroll
    for (int a = 0; a < 2; ++a)
#pragma unroll
        for (int b = 0; b < 2; ++b)
#pragma unroll
            for (int m = 0; m < 4; ++m)
#pragma unroll
                for (int n = 0; n < 2; ++n) acc[a][b][m][n] = (f32x4){0.f, 0.f, 0.f, 0.f};
    bf16x8 At[4][2], B0[2][2], B1[2][2];
    unsigned oAc[2][2], oAn[2][2];
    PG8_OFFS(oAc, 0);
    const char* cA = cur.a; const char* cB = cur.b;
    PG8_STAGE(PG8_SB(0, 0), cB, voffB); PG8_STAGE(PG8_SB(0, 1), cB + hstepB, voffB); PG8_STAGE(PG8_SA(0, 0), cA, oAc[0]); PG8_STAGE(PG8_SA(0, 1), cA, oAc[1]);
    if (wr == 1) PG8_BAR;
    PG8_WAIT_V(2); PG8_BAR;
    PG8_STAGE(PG8_SB(1, 0), cB + kstep, voffB); PG8_STAGE(PG8_SA(1, 0), cA + kstep, oAc[0]); PG8_STAGE(PG8_SB(1, 1), cB + hstepB + kstep, voffB);
    PG8_WAIT_V(6); PG8_BAR;
    for (;;) {
        const bool has_next = S.next(ui + 1, nxt);
        const char* nA = has_next ? nxt.a : cA; const char* nB = has_next ? nxt.b : cB;
        if constexpr (GATHER) { if (has_next) { PG8_OFFS(oAn, ui + 1); } else {
#pragma unroll
            for (int h = 0; h < 2; ++h)
#pragma unroll
                for (int i = 0; i < 2; ++i) oAn[h][i] = oAc[h][i]; } }
        for (int t = 0; t < nt; t += 2) {
            const bool last = (t == nt - 2);
            const char* a1 = cA + (size_t)(t + 1) * kstep;
            const char* a2 = last ? nA : cA + (size_t)(t + 2) * kstep; const char* b2 = last ? nB : cB + (size_t)(t + 2) * kstep;
            const char* a3 = a2 + kstep; const char* b3 = b2 + kstep;
            unsigned oAx[2][2];
#pragma unroll
            for (int h = 0; h < 2; ++h)
#pragma unroll
                for (int i = 0; i < 2; ++i) { if constexpr (GATHER) oAx[h][i] = last ? oAn[h][i] : oAc[h][i]; else oAx[h][i] = oAc[h][i]; }
            PG8_LDB(B0, 0, 0); PG8_LDB(B1, 0, 1); PG8_SCHED; PG8_LDA(At, 0, 0); PG8_STAGE(PG8_SA(1, 1), a1, oAc[1]);
            PG8_WAIT_V(8); PG8_WAIT_L(0); PG8_BAR; PG8_MMA(0, 0, At, B0); PG8_MMA(0, 1, At, B1); PG8_BAR; PG8_SCHED;
            PG8_LDA(At, 0, 1); PG8_STAGE(PG8_SB(0, 0), b2, voffB); PG8_STAGE(PG8_SB(0, 1), b2 + hstepB, voffB); PG8_STAGE(PG8_SA(0, 0), a2, oAx[0]);
            PG8_WAIT_V(8); PG8_WAIT_L(0); PG8_BAR; PG8_MMA(1, 0, At, B0); PG8_MMA(1, 1, At, B1); PG8_BAR; PG8_SCHED;
            PG8_LDB(B0, 1, 0); PG8_LDB(B1, 1, 1); PG8_SCHED; PG8_LDA(At, 1, 0); PG8_STAGE(PG8_SA(0, 1), a2, oAx[1]);
            PG8_WAIT_V(8); PG8_WAIT_L(0); PG8_BAR; PG8_MMA(0, 0, At, B0); PG8_MMA(0, 1, At, B1); PG8_BAR; PG8_SCHED;
            PG8_LDA(At, 1, 1); PG8_STAGE(PG8_SB(1, 0), b3, voffB); PG8_STAGE(PG8_SB(1, 1), b3 + hstepB, voffB); PG8_STAGE(PG8_SA(1, 0), a3, oAx[0]);
            PG8_WAIT_V(8); PG8_WAIT_L(0); PG8_BAR; PG8_MMA(1, 0, At, B0); PG8_MMA(1, 1, At, B1); PG8_BAR; PG8_SCHED;
        }
        if (wr == 0) PG8_BAR;
        E(acc, cur, wr, wc, fr, fq);
        if (!has_next) break;
#pragma unroll
        for (int a = 0; a < 2; ++a)
#pragma unroll
            for (int b = 0; b < 2; ++b)
#pragma unroll
                for (int m = 0; m < 4; ++m)
#pragma unroll
                    for (int n = 0; n < 2; ++n) acc[a][b][m][n] = (f32x4){0.f, 0.f, 0.f, 0.f};
        cur = nxt; cA = nA; cB = nB; ++ui;
        if constexpr (GATHER) {
#pragma unroll
        for (int h = 0; h < 2; ++h)
#pragma unroll
            for (int i = 0; i < 2; ++i) oAc[h][i] = oAn[h][i]; }
        if (wr == 1) PG8_BAR;
    }
    PG8_WAIT_V(0);
    PG8_BAR;
#undef PG8_SA
#undef PG8_SB
#undef PG8_STAGE
#undef PG8_LDA
#undef PG8_LDB
#undef PG8_MMA
#undef PG8_WAIT_V
#undef PG8_WAIT_L
#undef PG8_BAR
#undef PG8_SCHED
#undef PG8_OFFS
}
}
constexpr size_t al256(size_t x) { return (x + 255) & ~(size_t)255; }
constexpr size_t WS_CTL = 0, CTL_ZERO_BYTES = 1u << 20;
constexpr int CW_BAR = 4096;
constexpr size_t CTL_MOD = 65536;
constexpr int NIN_MAIN = 3328, NIN_F = 1024, NUP = 1792, KUP = 768;
constexpr size_t WS_WIN  = CTL_ZERO_BYTES;
constexpr size_t WS_WUP  = WS_WIN  + al256((size_t)2 * (NIN_MAIN + NIN_F) * D * 2);
constexpr size_t WS_WO   = WS_WUP  + al256((size_t)2 * NUP * KUP * 2);
constexpr size_t WS_WGU  = WS_WO   + al256((size_t)2 * D * D * 2);
constexpr size_t WS_WD   = WS_WGU  + al256((size_t)2 * NE * 2 * FF * D * 2);
constexpr size_t WS_DN   = WS_WD   + al256((size_t)2 * NE * D * FF * 2);
constexpr size_t WS_DL   = WS_DN   + al256((size_t)SEQ * 2 * SEQ * 2);
constexpr size_t WS_ROPS = WS_DL   + al256((size_t)CTXL * 2 * CTXL * 2);
constexpr size_t WS_ROPM = WS_ROPS + al256((size_t)SEQ * 32 * 8);
constexpr size_t WS_X    = WS_ROPM + al256((size_t)SEQ * 16 * 8);
constexpr size_t WS_H    = WS_X    + al256((size_t)T * D * 4);
constexpr size_t WS_PC   = WS_H    + al256((size_t)T * D * 2);
constexpr size_t WS_SQ   = WS_PC   + al256((size_t)T * 1536 * 2);
constexpr size_t WS_KS   = WS_SQ   + al256((size_t)T * 512 * 2);
constexpr size_t WS_VS   = WS_KS   + al256((size_t)NB * KVR * 128 * 2);
constexpr size_t WS_MCQ  = WS_VS   + al256((size_t)NB * KVR * 128 * 2);
constexpr size_t WS_QM   = WS_MCQ  + al256((size_t)T * 768 * 2);
constexpr size_t WS_KM   = WS_QM   + al256((size_t)T * 768 * 2);
constexpr size_t WS_VM   = WS_KM   + al256((size_t)NB * KVR * 768 * 2);
constexpr size_t WS_KPE  = WS_KM + (size_t)NB * KVR * 512 * 2;
constexpr size_t WS_GT   = WS_VM   + al256((size_t)NB * KVR * 512 * 2);
constexpr size_t WS_GTC  = WS_GT   + al256((size_t)NB * 512 * 8192 * 2);
constexpr size_t WS_YMIX = WS_GTC  + al256((size_t)NB * 512 * 512 * 2);
constexpr size_t WS_SSQ  = WS_YMIX + al256((size_t)T * D * 2);
constexpr size_t WS_MODP = WS_SSQ  + al256((size_t)T * 12 * 4);
constexpr int ADA_KC = 8;
constexpr size_t WS_AFF  = WS_MODP + al256((size_t)ADA_KC * 2 * 5 * 6 * D * 4);
constexpr size_t WS_POS  = WS_AFF  + al256((size_t)T * 16 * 4);
constexpr size_t WS_TOK  = WS_POS  + al256((size_t)T * 16 * 4);
constexpr size_t WS_ACT  = WS_TOK  + al256((size_t)NE * EROWS * 4);
constexpr size_t WS_Y    = WS_ACT  + al256((size_t)NE * EROWS * FF * 2);
constexpr size_t WS_GTF  = WS_Y    + al256((size_t)NE * EROWS * D * 2);
constexpr size_t WS_END  = WS_GTF  + al256((size_t)NB * 512 * SEQ * 2);

constexpr int RING_BYTES = 131072;
constexpr int LDS_TOK = RING_BYTES;
constexpr int LDS_MISC = LDS_TOK + 16 * 1024;
constexpr int LDS_ARGS = LDS_MISC + 256;
constexpr int LDS_BYTES = LDS_ARGS + 256;
__device__ __forceinline__ const float* lds_arg(LAS unsigned char* lds, int i) { const u32x2 v = *(const LAS u32x2*)(lds + LDS_ARGS + 8 * i); const unsigned lo = __builtin_amdgcn_readfirstlane(v.x), hi = __builtin_amdgcn_readfirstlane(v.y); return (const float*)(const GAS float*)(((unsigned long long)hi << 32) | lo); }
#define IN(i) lds_arg(lds, (i))

#define EPI_ARGS const f32x4 (&acc)[2][2][4][2], const pg8::Unit& u, int wr, int wc, int fr, int fq
#define EPI_OPAQUE() asm volatile("" : "+v"(fr), "+v"(fq))
__device__ __forceinline__ u32x4 pack8(const f32x4 a, const f32x4 b) { u32x4 w; w.x = cvtpk(a[0], a[1]); w.y = cvtpk(a[2], a[3]); w.z = cvtpk(b[0], b[1]); w.w = cvtpk(b[2], b[3]); return w; }
__device__ __forceinline__ u32x2 pack4(const f32x4 a) { u32x2 w; w.x = cvtpk(a[0], a[1]); w.y = cvtpk(a[2], a[3]); return w; }
__device__ __forceinline__ void rope4(f32x4& x1, f32x4& x2, const f32x2* cs) {
#pragma unroll
    for (int j = 0; j < 4; ++j) { const f32x2 c = cs[j]; const float a = x1[j], b = x2[j]; x1[j] = a * c.x - b * c.y; x2[j] = b * c.x + a * c.y; }
}

struct EpiInproj {
    unsigned char* ws;
    __device__ __forceinline__ void operator()(EPI_ARGS) const { EPI_OPAQUE();
        bf16* const PC = (bf16*)(ws + WS_PC); bf16* const SQ = (bf16*)(ws + WS_SQ); bf16* const KS = (bf16*)(ws + WS_KS); bf16* const VS = (bf16*)(ws + WS_VS); bf16* const MCQ = (bf16*)(ws + WS_MCQ);
        bf16* const KM = (bf16*)(ws + WS_KM); bf16* const GT = (bf16*)(ws + WS_GT); bf16* const GTC = (bf16*)(ws + WS_GTC); float* const SSQ = (float*)(ws + WS_SSQ);
        const f32x2* const ROPS = (const f32x2*)(ws + WS_ROPS); const f32x2* const ROPM = (const f32x2*)(ws + WS_ROPM);
        if (u.kind == 1) {
#pragma unroll
            for (int ai = 0; ai < 2; ++ai)
#pragma unroll
                for (int m = 0; m < 4; ++m) { const int r = 256 * u.pm + 128 * ai + 64 * wr + 16 * m + fr, part = r >> 9, j = r & 511;
#pragma unroll
                    for (int bj = 0; bj < 2; ++bj) { const int tok = 256 * u.pn + 128 * bj + 32 * wc + 8 * fq; bf16* dst;
                        if (tok < TL) dst = GT + ((size_t)((tok >> 12) * 512 + j) * 8192 + part * 4096 + (tok & 4095));
                        else { const int tc = tok - TL; dst = GTC + ((size_t)((tc >> 8) * 512 + j) * 512 + part * 256 + (tc & 255)); }
                        *(u32x4*)dst = pack8(acc[ai][bj][m][0], acc[ai][bj][m][1]); } }
            return;
        }
        const int pn = u.pn;
#pragma unroll
        for (int ai = 0; ai < 2; ++ai)
#pragma unroll
            for (int m = 0; m < 4; ++m) {
                int t = 256 * u.pm + 128 * ai + 64 * wr + 16 * m + fr; asm volatile("" : "+v"(t)); const bool lat = t < TL; const int npos = t & (SEQ - 1);
                if (pn < 6) {
#pragma unroll
                    for (int bj = 0; bj < 2; ++bj) *(u32x4*)(PC + (size_t)t * 1536 + 256 * pn + 128 * bj + 32 * wc + 8 * fq) = pack8(acc[ai][bj][m][0], acc[ai][bj][m][1]);
                } else if (pn < 8) {
#pragma unroll
                    for (int bj = 0; bj < 2; ++bj) { const int hc = 256 * (pn - 6) + 128 * bj + 32 * wc + 8 * fq, head = hc >> 6, a = (hc & 63) >> 3;
                        f32x4 x1 = acc[ai][bj][m][0], x2 = acc[ai][bj][m][1];
                        if (lat) rope4(x1, x2, ROPS + npos * 32 + 4 * a);
                        x1 *= QSC_S; x2 *= QSC_S;
                        bf16* o = SQ + (size_t)t * 512 + head * 64 + 4 * a; *(u32x2*)o = pack4(x1); *(u32x2*)(o + 32) = pack4(x2); }
                } else if (pn == 8) {
                    const int kr = kv_row(t);
                    { const int hc = 32 * wc + 8 * fq, head = hc >> 6, a = (hc & 63) >> 3; f32x4 x1 = acc[ai][0][m][0], x2 = acc[ai][0][m][1];
                      if (lat) rope4(x1, x2, ROPS + npos * 32 + 4 * a);
                      bf16* o = KS + (size_t)kr * 128 + head * 64 + 4 * a; *(u32x2*)o = pack4(x1); *(u32x2*)(o + 32) = pack4(x2); }
                    *(u32x4*)(VS + (size_t)kr * 128 + 32 * wc + 8 * fq) = pack8(acc[ai][1][m][0], acc[ai][1][m][1]);
                } else if (pn < 12) {
                    const int cb = pn < 11 ? 256 * (pn - 9) : 512; float s = 0.f;
#pragma unroll
                    for (int bj = 0; bj < 2; ++bj) { const f32x4 v0 = acc[ai][bj][m][0], v1 = acc[ai][bj][m][1];
                        *(u32x4*)(MCQ + (size_t)t * 768 + cb + 128 * bj + 32 * wc + 8 * fq) = pack8(v0, v1);
                        s += (v0[0] * v0[0] + v0[1] * v0[1]) + (v0[2] * v0[2] + v0[3] * v0[3]) + (v1[0] * v1[0] + v1[1] * v1[1]) + (v1[2] * v1[2] + v1[3] * v1[3]); }
                    s += __shfl_xor(s, 16); s += __shfl_xor(s, 32);
                    if (fq == 0) SSQ[(size_t)t * 12 + (pn - 9) * 4 + wc] = s;
                } else {
                    if (wc == 0) { const int a = fq; f32x4 x1 = acc[ai][0][m][0], x2 = acc[ai][0][m][1];
                        if (lat) rope4(x1, x2, ROPM + npos * 16 + 4 * a);
                        bf16* o = (bf16*)(ws + WS_KPE) + (size_t)kv_row(t) * 32 + 4 * a; *(u32x2*)o = pack4(x1); *(u32x2*)(o + 16) = pack4(x2); }
                }
                asm volatile("" ::: "memory");
            }
    }
};

struct EpiUp {
    unsigned char* ws;
    __device__ __forceinline__ void operator()(EPI_ARGS) const { EPI_OPAQUE();
        bf16* const QM = (bf16*)(ws + WS_QM); bf16* const KM = (bf16*)(ws + WS_KM); bf16* const VM = (bf16*)(ws + WS_VM); const float* const SSQ = (const float*)(ws + WS_SSQ); const f32x2* const ROPM = (const f32x2*)(ws + WS_ROPM);
        const int pn = u.pn; const bool isq = (u.aux == 0);
#pragma unroll
        for (int ai = 0; ai < 2; ++ai)
#pragma unroll
            for (int m = 0; m < 4; ++m) {
                int t = 256 * u.pm + 128 * ai + 64 * wr + 16 * m + fr; asm volatile("" : "+v"(t)); const bool lat = t < TL; const int npos = t & (SEQ - 1);
                if (isq) {
                    const f32x4 sa = *(const f32x4*)(SSQ + (size_t)t * 12), sb = *(const f32x4*)(SSQ + (size_t)t * 12 + 4);
                    const float rs = rsqrtf((((sa[0] + sa[1]) + (sa[2] + sa[3])) + ((sb[0] + sb[1]) + (sb[2] + sb[3]))) * (1.0f / 512.0f) + EPS) * QSC_M;
#pragma unroll
                    for (int bj = 0; bj < 2; ++bj) { const int c0 = 256 * pn + 128 * bj + 32 * wc + 8 * fq, head = c0 / 96, w = c0 - head * 96;
                        f32x4 x1 = acc[ai][bj][m][0], x2 = acc[ai][bj][m][1];
                        if (w < 64) { x1 *= rs; x2 *= rs; *(u32x4*)(QM + (size_t)t * 768 + c0) = pack8(x1, x2); }
                        else { const int a = (w - 64) >> 3; if (lat) rope4(x1, x2, ROPM + npos * 16 + 4 * a); x1 *= rs; x2 *= rs;
                            bf16* o = QM + (size_t)t * 768 + head * 96 + 64 + 4 * a; *(u32x2*)o = pack4(x1); *(u32x2*)(o + 16) = pack4(x2); } }
                } else {
                    const f32x4 sc = *(const f32x4*)(SSQ + (size_t)t * 12 + 8);
                    const float rs = rsqrtf(((sc[0] + sc[1]) + (sc[2] + sc[3])) * (1.0f / 256.0f) + EPS); const int kr = kv_row(t);
#pragma unroll
                    for (int bj = 0; bj < 2; ++bj) { const int c0 = 256 * pn + 128 * bj + 32 * wc + 8 * fq, head = c0 >> 7, w = c0 & 127;
                        const f32x4 x1 = acc[ai][bj][m][0] * rs, x2 = acc[ai][bj][m][1] * rs;
                        if (w < 64) *(u32x4*)(KM + (size_t)kr * 512 + head * 64 + w) = pack8(x1, x2);
                        else *(u32x4*)(VM + (size_t)kr * 512 + head * 64 + (w - 64)) = pack8(x1, x2); } }
                asm volatile("" ::: "memory");
            }
    }
};

struct EpiFnet {
    bf16* YMIX;
    __device__ __forceinline__ void operator()(EPI_ARGS) const { EPI_OPAQUE();
#pragma unroll
        for (int ai = 0; ai < 2; ++ai)
#pragma unroll
            for (int m = 0; m < 4; ++m) { const int t = u.aux * SEQ + 256 * u.pm + 128 * ai + 64 * wr + 16 * m + fr;
#pragma unroll
                for (int bj = 0; bj < 2; ++bj) *(u32x4*)(YMIX + (size_t)t * D + 1024 + 256 * u.pn + 128 * bj + 32 * wc + 8 * fq) = pack8(acc[ai][bj][m][0], acc[ai][bj][m][1]); }
    }
};

struct EpiOut {
    const float *xl, *xc; const bf16* xb; bf16* X; const float* MODL;
    __device__ __forceinline__ void operator()(EPI_ARGS) const { EPI_OPAQUE();
        const int tb = 256 * u.pm, cb = 256 * u.pn + 32 * wc + 8 * fq; const float* g1 = MODL + mod_row(tb) * 6 * D + 2 * D + cb;
        f32x4 gv[2][2];
#pragma unroll
        for (int bj = 0; bj < 2; ++bj)
#pragma unroll
            for (int n = 0; n < 2; ++n) gv[bj][n] = *(const f32x4*)(g1 + 128 * bj + 4 * n);
        if (xb) {
#pragma unroll
            for (int ai = 0; ai < 2; ++ai)
#pragma unroll
                for (int m2 = 0; m2 < 4; m2 += 2) { u32x4 w[2][2];
#pragma unroll
                    for (int mm = 0; mm < 2; ++mm) { const bf16* xin = xb + (size_t)(tb + 128 * ai + 64 * wr + 16 * (m2 + mm) + fr) * D + cb; w[mm][0] = *(const u32x4*)xin; w[mm][1] = *(const u32x4*)(xin + 128); }
#pragma unroll
                    for (int mm = 0; mm < 2; ++mm) { bf16* xo = X + (size_t)(tb + 128 * ai + 64 * wr + 16 * (m2 + mm) + fr) * D + cb;
#pragma unroll
                        for (int bj = 0; bj < 2; ++bj) { const u32x4 q = w[mm][bj]; const f32x4 x0 = {bf_lo(q.x), bf_hi(q.x), bf_lo(q.y), bf_hi(q.y)}, x1 = {bf_lo(q.z), bf_hi(q.z), bf_lo(q.w), bf_hi(q.w)};
                            *(u32x4*)(xo + 128 * bj) = pack8(x0 + gv[bj][0] * acc[ai][bj][m2 + mm][0], x1 + gv[bj][1] * acc[ai][bj][m2 + mm][1]); } }
                    asm volatile("" ::: "memory"); }
        } else {
#pragma unroll
            for (int ai = 0; ai < 2; ++ai)
#pragma unroll
                for (int m = 0; m < 4; ++m) { const int t = tb + 128 * ai + 64 * wr + 16 * m + fr; const float* xin = (t < TL ? xl + (size_t)t * D : xc + (size_t)(t - TL) * D) + cb; bf16* xo = X + (size_t)t * D + cb;
                    f32x4 xi[2][2];
#pragma unroll
                    for (int bj = 0; bj < 2; ++bj)
#pragma unroll
                        for (int n = 0; n < 2; ++n) xi[bj][n] = *(const f32x4*)(xin + 128 * bj + 4 * n);
#pragma unroll
                    for (int bj = 0; bj < 2; ++bj) *(u32x4*)(xo + 128 * bj) = pack8(xi[bj][0] + gv[bj][0] * acc[ai][bj][m][0], xi[bj][1] + gv[bj][1] * acc[ai][bj][m][1]);
                    asm volatile("" ::: "memory"); }
        }
    }
};

struct EpiGU {
    bf16* ACT;
    __device__ __forceinline__ void operator()(EPI_ARGS) const { EPI_OPAQUE();
#pragma unroll
        for (int ai = 0; ai < 2; ++ai)
#pragma unroll
            for (int m = 0; m < 4; ++m) { const int row = u.aux * EROWS + 256 * u.pm + 128 * ai + 64 * wr + 16 * m + fr; f32x4 o[2];
#pragma unroll
                for (int n = 0; n < 2; ++n) { const f32x4 g = acc[ai][0][m][n], up = acc[ai][1][m][n];
#pragma unroll
                    for (int j = 0; j < 4; ++j) o[n][j] = g[j] * __builtin_amdgcn_rcpf(1.0f + __builtin_amdgcn_exp2f(-g[j] * LOG2E)) * up[j]; }
                *(u32x4*)(ACT + (size_t)row * FF + 128 * u.pn + 32 * wc + 8 * fq) = pack8(o[0], o[1]); }
    }
};

struct EpiDown {
    bf16* Y;
    __device__ __forceinline__ void operator()(EPI_ARGS) const { EPI_OPAQUE();
#pragma unroll
        for (int ai = 0; ai < 2; ++ai)
#pragma unroll
            for (int m = 0; m < 4; ++m) { const int row = u.aux * EROWS + 256 * u.pm + 128 * ai + 64 * wr + 16 * m + fr;
#pragma unroll
                for (int bj = 0; bj < 2; ++bj) *(u32x4*)(Y + (size_t)row * D + 256 * u.pn + 128 * bj + 32 * wc + 8 * fq) = pack8(acc[ai][bj][m][0], acc[ai][bj][m][1]); }
    }
};

__device__ __forceinline__ void static_tile(int L, int nM, int nN, int& pm, int& pn) {
    const int nwg = nM * nN; int wgid = L; { const int q = nwg / 8, r = nwg % 8, xcd = wgid % 8, off = wgid / 8; wgid = (xcd < r ? xcd * (q + 1) : r * (q + 1) + (xcd - r) * q) + off; }
    const int nig = 8 * nN, gid = wgid / nig, fm = gid * 8, gsz = (nM - fm) < 8 ? (nM - fm) : 8;
    pm = fm + ((wgid % nig) % gsz); pn = (wgid % nig) / gsz;
}
struct SchedInproj {
    const char *H, *WM, *WF; int G, c;
    __device__ __forceinline__ bool next(int i, pg8::Unit& u) const {
        const int L = i * G + c; constexpr int NMAIN = 68 * 13;
        if (L < NMAIN) { static_tile(L, 68, 13, u.pm, u.pn); u.kind = 0; u.aux = 0; u.a = H + (size_t)u.pm * 256 * D * 2; u.b = WM + (size_t)u.pn * 256 * D * 2; return true; }
        const int k = L - NMAIN; if (k >= 4 * 68) return false;
        u.pm = k & 3; u.pn = k >> 2; u.kind = 1; u.aux = 0; u.a = WF + (size_t)u.pm * 256 * D * 2; u.b = H + (size_t)u.pn * 256 * D * 2; return true;
    }
    __device__ __forceinline__ unsigned rowoff(int, int) const { return 0u; }
};
struct SchedPlain {
    const char *A, *B; int nM, nN, G, c; unsigned lda, ldb; int aux;
    __device__ __forceinline__ bool next(int i, pg8::Unit& u) const {
        const int L = i * G + c; if (L >= nM * nN) return false;
        static_tile(L, nM, nN, u.pm, u.pn); u.kind = 0; u.aux = aux; u.a = A + (size_t)u.pm * 256 * lda; u.b = B + (size_t)u.pn * 256 * ldb; return true;
    }
    __device__ __forceinline__ unsigned rowoff(int, int) const { return 0u; }
};
struct SchedFnet {
    const char *DN, *GT; int c, G;
    __device__ __forceinline__ bool next(int i, pg8::Unit& u) const {
        int pm, bp;
        if (G == 256) { const int x = c & 7, li = c >> 3; if (i > 0 || li >= 16) return false; pm = (x & 3) * 4 + (li & 3); bp = (x >> 2) * 4 + (li >> 2); }
        else { const int id = c + i * G; if (id >= 128) return false; pm = id & 15; bp = id >> 4; }
        const int b = bp >> 1, pn = bp & 1;
        u.pm = pm; u.pn = pn; u.kind = 0; u.aux = b; u.a = DN + (size_t)pm * 256 * SEQ * 2; u.b = GT + (size_t)(b * 512 + pn * 256) * SEQ * 2; return true;
    }
    __device__ __forceinline__ unsigned rowoff(int, int) const { return 0u; }
};
struct SchedFnetC {
    const char *DL, *GTC; int c, G;
    __device__ __forceinline__ bool next(int i, pg8::Unit& u) const {
        int id; if (G == 256) { if (i > 0 || (c >> 3) != 8) return false; id = c & 7; } else { id = c + i * G; if (id >= 8) return false; }
        u.pm = 0; u.pn = id & 1; u.aux = id >> 1; u.kind = 0; u.a = DL; u.b = GTC + (size_t)(u.aux * 512 + u.pn * 256) * 512 * 2; return true;
    }
    __device__ __forceinline__ unsigned rowoff(int, int) const { return 0u; }
};
struct EpiFnetC {
    bf16* YMIX;
    __device__ __forceinline__ void operator()(EPI_ARGS) const { EPI_OPAQUE();
#pragma unroll
        for (int ai = 0; ai < 2; ++ai)
#pragma unroll
            for (int m = 0; m < 4; ++m) { const int t = TL + u.aux * CTXL + 128 * ai + 64 * wr + 16 * m + fr;
#pragma unroll
                for (int bj = 0; bj < 2; ++bj) *(u32x4*)(YMIX + (size_t)t * D + 1024 + 256 * u.pn + 128 * bj + 32 * wc + 8 * fq) = pack8(acc[ai][bj][m][0], acc[ai][bj][m][1]); }
    }
};
struct SchedMoe {
    const char *A, *B; int npm, nN, G, c; size_t sA, sB; unsigned ldb; const LAS int* tokl;
    __device__ __forceinline__ bool next(int i, pg8::Unit& u) const {
        const int per = npm * nN, nwg = NE * per; const int L = i * G + c; if (L >= nwg) return false;
        const int wgid = (L & 7) * (nwg >> 3) + (L >> 3);
        const int e = wgid / per, rem = wgid - e * per; u.pn = rem / npm; u.pm = rem - u.pn * npm; u.aux = e; u.kind = 0;
        u.a = A + (size_t)e * sA + (size_t)u.pm * 256 * (size_t)(D * 2) * (sA ? 1 : 0); u.b = B + (size_t)e * sB + (size_t)u.pn * 256 * ldb; return true;
    }
    __device__ __forceinline__ unsigned rowoff(int i, int r) const { return (unsigned)tokl[i * 256 + r] * (unsigned)(D * 2); }
};
namespace att {
constexpr int NSLOT = 4, LK = 0, KSLOT = 12288, LV = NSLOT * KSLOT, VSLOT = 8192, LWS = LV + NSLOT * VSLOT, LOST = LWS + NWAVES * 256, LDS_NEED = LOST + NWAVES * 4096;
static_assert(LDS_NEED <= RING_BYTES, "attention LDS");
typedef LAS const char* lds_cptr;
#define ATT_SBAR() __builtin_amdgcn_sched_barrier(0)
__device__ __forceinline__ int crow(int r, int hi) { return (r & 3) + 8 * (r >> 2) + 4 * hi; }
__device__ __forceinline__ void glds16(const void* gsrc, unsigned lds_dst) { unsigned keep;
    asm volatile("s_mov_b32 %0, m0\n\ts_mov_b32 m0, %2\n\ts_nop 0\n\tglobal_load_lds_dwordx4 %1, off\n\ts_mov_b32 m0, %0" : "=&s"(keep) : "v"(gsrc), "s"(lds_dst) : "memory"); }
__device__ __forceinline__ float vmax3(float a, float b, float c) { float d; asm("v_max3_f32 %0, %1, %2, %3" : "=v"(d) : "v"(a), "v"(b), "v"(c)); return d; }
__device__ __forceinline__ float rowmax(const f32x16& p0, const f32x16& p1) {
    float a = fmaxf(p0[0], p1[0]);
#pragma unroll
    for (int r = 1; r < 16; ++r) a = fmaxf(a, fmaxf(p0[r], p1[r]));
    auto rr = __builtin_amdgcn_permlane32_swap(__float_as_uint(a), __float_as_uint(a), false, false);
    return fmaxf(__uint_as_float(rr[0]), __uint_as_float(rr[1]));
}
__device__ __forceinline__ void pv(f32x16* o, int vb, bf16x8 pa0, bf16x8 pa1, bf16x8 pa2, bf16x8 pa3) {
    s16x4 lo[2][4], hi[2][4];
#pragma unroll
    for (int d0 = 0; d0 < 2; ++d0)
#pragma unroll
        for (int ks = 0; ks < 4; ++ks) {
            asm volatile("ds_read_b64_tr_b16 %0,%1 offset:%c2" : "=&v"(lo[d0][ks]) : "v"(vb), "i"(d0 * 4096 + ks * 1024) : "memory");
            asm volatile("ds_read_b64_tr_b16 %0,%1 offset:%c2" : "=&v"(hi[d0][ks]) : "v"(vb), "i"(d0 * 4096 + ks * 1024 + 512) : "memory"); }
    asm volatile("s_waitcnt lgkmcnt(0)" ::: "memory"); ATT_SBAR();
#define ATT_PK(d, k) (bf16x8){lo[d][k][0], lo[d][k][1], lo[d][k][2], lo[d][k][3], hi[d][k][0], hi[d][k][1], hi[d][k][2], hi[d][k][3]}
    o[0] = __builtin_amdgcn_mfma_f32_32x32x16_bf16(pa0, ATT_PK(0, 0), o[0], 0, 0, 0); o[1] = __builtin_amdgcn_mfma_f32_32x32x16_bf16(pa0, ATT_PK(1, 0), o[1], 0, 0, 0);
    o[0] = __builtin_amdgcn_mfma_f32_32x32x16_bf16(pa1, ATT_PK(0, 1), o[0], 0, 0, 0); o[1] = __builtin_amdgcn_mfma_f32_32x32x16_bf16(pa1, ATT_PK(1, 1), o[1], 0, 0, 0);
    o[0] = __builtin_amdgcn_mfma_f32_32x32x16_bf16(pa2, ATT_PK(0, 2), o[0], 0, 0, 0); o[1] = __builtin_amdgcn_mfma_f32_32x32x16_bf16(pa2, ATT_PK(1, 2), o[1], 0, 0, 0);
    o[0] = __builtin_amdgcn_mfma_f32_32x32x16_bf16(pa3, ATT_PK(0, 3), o[0], 0, 0, 0); o[1] = __builtin_amdgcn_mfma_f32_32x32x16_bf16(pa3, ATT_PK(1, 3), o[1], 0, 0, 0);
#undef ATT_PK
}
template <int DQ, bool SWA>
__device__ __forceinline__ void attn_unit(LAS unsigned char* lds, const bf16* Qw, const int qld, const bf16* Kh, const int kld, const bf16* Kpe, const bf16* Vh, const int vld, bf16* Ow,
                                          const int a0, const int n1, const int n2, const int qpos0, const float mhat0, const float l0) {
    constexpr int NKS = DQ / 16; constexpr float THR = 6.0f;
    int tid_ = threadIdx.x; asm volatile("" : "+v"(tid_));
    const int tid = tid_, lane = tid & 63, r32 = lane & 31, hi = lane >> 5; const int wid = __builtin_amdgcn_readfirstlane(tid >> 6);
    const unsigned lds0 = (unsigned)(uintptr_t)lds;
    LAS float* wsf = (LAS float*)(lds + LWS) + wid * 64;
    const bf16* ksrc0 = Kh + (size_t)lane * kld + wid * 8;
    const bf16* ksrc1 = Kpe + (size_t)lane * 32 + (wid & 3) * 8;
    const bf16* vsrc = Vh + (size_t)(16 * (wid & 3) + (lane >> 2)) * vld + (wid >> 2) * 32 + (lane & 3) * 8;
    const unsigned kdst0 = lds0 + LK + wid * 1024, kdst1 = lds0 + LK + (8 + (wid & 3)) * 1024, vdst = lds0 + LV + wid * 1024;
    const int NT = n1 + n2;
#define ATT_TILE(i) ((i) < n1 ? a0 + (i) : 64 + (i) - n1)
#define ATT_DMA(i) do { const size_t ko_ = (size_t)ATT_TILE(i) * 64; const int s_ = (i) & 3; glds16(ksrc0 + ko_ * kld, (unsigned)__builtin_amdgcn_readfirstlane(kdst0 + s_ * KSLOT)); \
        if (DQ == 96) glds16(ksrc1 + ko_ * 32, (unsigned)__builtin_amdgcn_readfirstlane(kdst1 + s_ * KSLOT)); \
        glds16(vsrc + ko_ * vld, (unsigned)__builtin_amdgcn_readfirstlane(vdst + s_ * VSLOT)); } while (0)
#define ATT_WAIT_BAR(N) asm volatile("s_waitcnt vmcnt(" #N ") lgkmcnt(0)\n\ts_barrier" ::: "memory")
#define ATT_QK(P0, P1, i) do { const lds_cptr kp_ = kp0 + ((i) & 3) * KSLOT; P0 = f32x16{}; P1 = f32x16{}; \
        _Pragma("unroll") for (int d0 = 0; d0 < NKS; ++d0) { const bf16x8 b0_ = *(const LAS bf16x8*)(kp_ + d0 * 2048), b1_ = *(const LAS bf16x8*)(kp_ + d0 * 2048 + 512); \
            P0 = __builtin_amdgcn_mfma_f32_32x32x16_bf16(b0_, qr[d0], P0, 0, 0, 0); P1 = __builtin_amdgcn_mfma_f32_32x32x16_bf16(b1_, qr[d0], P1, 0, 0, 0); } } while (0)
    bf16x8 qr[NKS];
#pragma unroll
    for (int d0 = 0; d0 < NKS; ++d0) qr[d0] = *(const bf16x8*)(Qw + (size_t)r32 * qld + d0 * 16 + hi * 8);
    if (wid >= 4) __builtin_amdgcn_s_setprio(1);
    ATT_DMA(0); ATT_DMA(1); ATT_DMA(2);
    float mhat = mhat0, l_reg = (hi == 0) ? l0 : 0.f; f32x16 o[2]; o[0] = f32x16{}; o[1] = f32x16{};
    const int vb0 = (int)(lds0 + LV) + ((lane >> 4) & 1) * 32 + (lane & 3) * 8 + (4 * hi + ((lane & 15) >> 2)) * 64;
    const lds_cptr kp0 = (lds_cptr)(lds + LK) + hi * 1024 + r32 * 16;
    const int qpos = qpos0 + wid * 32 + r32;
#define ATT_MASK(P0, P1, i) do { if (SWA) { const int kb_ = ((i) < n1) ? 64 * (a0 + (i)) + 4 * hi - qpos : 0; \
        _Pragma("unroll") for (int r = 0; r < 16; ++r) { const int rel_ = kb_ + (r & 3) + 8 * (r >> 2); P0[r] = (rel_ > 128 || rel_ < -128) ? -1e30f : P0[r]; P1[r] = (rel_ + 32 > 128 || rel_ + 32 < -128) ? -1e30f : P1[r]; } } } while (0)
#define ATT_RESCALE(rm_) do { if (__any((rm_) > mhat + THR)) { const float mn_ = fmaxf(mhat, (rm_)), f_ = __builtin_amdgcn_exp2f(mhat - mn_); l_reg *= f_; mhat = mn_; \
        if (hi == 0) wsf[r32] = f_; asm volatile("s_waitcnt lgkmcnt(0)" ::: "memory"); \
        _Pragma("unroll") for (int d = 0; d < 2; ++d) _Pragma("unroll") for (int r = 0; r < 16; ++r) o[d][r] *= wsf[crow(r, hi)]; \
        asm volatile("s_waitcnt lgkmcnt(0)" ::: "memory"); } } while (0)
#define ATT_RESCALE_N(rp_, N0_, N1_) do { if (__any((rp_) > THR)) { const float d_ = fmaxf((rp_), 0.f), f_ = __builtin_amdgcn_exp2f(-d_); l_reg *= f_; \
        if (hi == 0) wsf[r32] = f_; asm volatile("s_waitcnt lgkmcnt(0)" ::: "memory"); \
        _Pragma("unroll") for (int d = 0; d < 2; ++d) _Pragma("unroll") for (int r = 0; r < 16; ++r) o[d][r] *= wsf[crow(r, hi)]; \
        _Pragma("unroll") for (int r = 0; r < 16; ++r) { N0_[r] -= d_; N1_[r] -= d_; negm[r] -= d_; } \
        asm volatile("s_waitcnt lgkmcnt(0)" ::: "memory"); } } while (0)
    f32x16 p0, p1, n0, n1v, negm;
    if (DQ == 96) ATT_WAIT_BAR(6); else ATT_WAIT_BAR(4);
    ATT_QK(p0, p1, 0); ATT_MASK(p0, p1, 0);
    { const float rm0 = rowmax(p0, p1); ATT_RESCALE(rm0); }
#pragma unroll
    for (int r = 0; r < 16; ++r) { p0[r] -= mhat; p1[r] -= mhat; negm[r] = -mhat; }
    constexpr int CB6[7] = {0, 4, 8, 12, 16, 20, 24}, CB4[5] = {0, 6, 12, 18, 24};
    auto step = [&](f32x16& P0, f32x16& P1, f32x16& N0, f32x16& N1, const int it) __attribute__((always_inline)) {
        if (it + 2 < NT) { if (DQ == 96) ATT_WAIT_BAR(3); else ATT_WAIT_BAR(2); } else ATT_WAIT_BAR(0);
        if (it + 3 < NT) ATT_DMA(it + 3);
        bf16x8 kf[2 * NKS];
        { const lds_cptr kp_ = kp0 + ((it + 1) & 3) * KSLOT;
#pragma unroll
          for (int d0 = 0; d0 < NKS; ++d0) { kf[2 * d0] = *(const LAS bf16x8*)(kp_ + d0 * 2048); kf[2 * d0 + 1] = *(const LAS bf16x8*)(kp_ + d0 * 2048 + 512); } }
        f32x2 sacc = {0.f, 0.f};
        ATT_SBAR();
#pragma unroll
        for (int d0 = 0; d0 < NKS; ++d0) {
            N0 = __builtin_amdgcn_mfma_f32_32x32x16_bf16(kf[2 * d0], qr[d0], d0 ? N0 : negm, 0, 0, 0); N1 = __builtin_amdgcn_mfma_f32_32x32x16_bf16(kf[2 * d0 + 1], qr[d0], d0 ? N1 : negm, 0, 0, 0);
            const int lo_ = (NKS == 6) ? CB6[d0] : CB4[d0], hi_ = (NKS == 6) ? CB6[d0 + 1] : CB4[d0 + 1];
#pragma unroll
            for (int i = 0; i < 32; i += 2) if (i >= lo_ && i < hi_) { if (i < 16) { P0[i] = __builtin_amdgcn_exp2f(P0[i]); P0[i + 1] = __builtin_amdgcn_exp2f(P0[i + 1]); sacc += (f32x2){P0[i], P0[i + 1]}; }
                else { P1[i - 16] = __builtin_amdgcn_exp2f(P1[i - 16]); P1[i - 15] = __builtin_amdgcn_exp2f(P1[i - 15]); sacc += (f32x2){P1[i - 16], P1[i - 15]}; } }
            ATT_SBAR();
        }
        const u32x4 pw0 = {cvtpk(P0[0], P0[1]), cvtpk(P0[2], P0[3]), cvtpk(P0[4], P0[5]), cvtpk(P0[6], P0[7])}, pw1 = {cvtpk(P0[8], P0[9]), cvtpk(P0[10], P0[11]), cvtpk(P0[12], P0[13]), cvtpk(P0[14], P0[15])};
        const u32x4 pw2 = {cvtpk(P1[0], P1[1]), cvtpk(P1[2], P1[3]), cvtpk(P1[4], P1[5]), cvtpk(P1[6], P1[7])};
        { const int vb = vb0 + (it & 3) * VSLOT; s16x4 vlo[2][4], vhi[2][4];
#pragma unroll
          for (int d0 = 0; d0 < 2; ++d0)
#pragma unroll
              for (int ks = 0; ks < 4; ++ks) {
                  asm volatile("ds_read_b64_tr_b16 %0,%1 offset:%c2" : "=&v"(vlo[d0][ks]) : "v"(vb), "i"(d0 * 4096 + ks * 1024) : "memory");
                  asm volatile("ds_read_b64_tr_b16 %0,%1 offset:%c2" : "=&v"(vhi[d0][ks]) : "v"(vb), "i"(d0 * 4096 + ks * 1024 + 512) : "memory"); }
          asm volatile("s_waitcnt lgkmcnt(0)" ::: "memory"); ATT_SBAR();
#define ATT_VF(d, k) (bf16x8){vlo[d][k][0], vlo[d][k][1], vlo[d][k][2], vlo[d][k][3], vhi[d][k][0], vhi[d][k][1], vhi[d][k][2], vhi[d][k][3]}
          o[0] = __builtin_amdgcn_mfma_f32_32x32x16_bf16(__builtin_bit_cast(bf16x8, pw0), ATT_VF(0, 0), o[0], 0, 0, 0); o[1] = __builtin_amdgcn_mfma_f32_32x32x16_bf16(__builtin_bit_cast(bf16x8, pw0), ATT_VF(1, 0), o[1], 0, 0, 0);
#pragma unroll
          for (int i = 8; i < 12; i += 2) { P1[i] = __builtin_amdgcn_exp2f(P1[i]); P1[i + 1] = __builtin_amdgcn_exp2f(P1[i + 1]); sacc += (f32x2){P1[i], P1[i + 1]}; }
          ATT_MASK(N0, N1, it + 1); ATT_SBAR();
          o[0] = __builtin_amdgcn_mfma_f32_32x32x16_bf16(__builtin_bit_cast(bf16x8, pw1), ATT_VF(0, 1), o[0], 0, 0, 0); o[1] = __builtin_amdgcn_mfma_f32_32x32x16_bf16(__builtin_bit_cast(bf16x8, pw1), ATT_VF(1, 1), o[1], 0, 0, 0);
#pragma unroll
          for (int i = 12; i < 16; i += 2) { P1[i] = __builtin_amdgcn_exp2f(P1[i]); P1[i + 1] = __builtin_amdgcn_exp2f(P1[i + 1]); sacc += (f32x2){P1[i], P1[i + 1]}; }
          const u32x4 pw3 = {cvtpk(P1[8], P1[9]), cvtpk(P1[10], P1[11]), cvtpk(P1[12], P1[13]), cvtpk(P1[14], P1[15])};
          l_reg += sacc[0] + sacc[1];
          ATT_SBAR();
          o[0] = __builtin_amdgcn_mfma_f32_32x32x16_bf16(__builtin_bit_cast(bf16x8, pw2), ATT_VF(0, 2), o[0], 0, 0, 0); o[1] = __builtin_amdgcn_mfma_f32_32x32x16_bf16(__builtin_bit_cast(bf16x8, pw2), ATT_VF(1, 2), o[1], 0, 0, 0);
          float ra = vmax3(N0[0], N1[0], N0[1]);
#pragma unroll
          for (int r = 1; r < 8; ++r) ra = vmax3(ra, N1[r], N0[r < 7 ? r + 1 : r]);
          ATT_SBAR();
          o[0] = __builtin_amdgcn_mfma_f32_32x32x16_bf16(__builtin_bit_cast(bf16x8, pw3), ATT_VF(0, 3), o[0], 0, 0, 0); o[1] = __builtin_amdgcn_mfma_f32_32x32x16_bf16(__builtin_bit_cast(bf16x8, pw3), ATT_VF(1, 3), o[1], 0, 0, 0);
#pragma unroll
          for (int r = 8; r < 16; ++r) ra = vmax3(ra, N0[r], N1[r]);
#undef ATT_VF
          auto rr = __builtin_amdgcn_permlane32_swap(__float_as_uint(ra), __float_as_uint(ra), false, false); const float rm = fmaxf(__uint_as_float(rr[0]), __uint_as_float(rr[1]));
          ATT_SBAR();
          if (it + 1 < NT) ATT_RESCALE_N(rm, N0, N1); }
    };
    for (int it = 0; it < NT; it += 2) { step(p0, p1, n0, n1v, it); if (it + 1 < NT) step(n0, n1v, p0, p1, it + 1); }
#undef ATT_MASK
#undef ATT_RESCALE
#undef ATT_RESCALE_N
    { auto rr = __builtin_amdgcn_permlane32_swap(__float_as_uint(l_reg), __float_as_uint(l_reg), false, false); l_reg = __uint_as_float(rr[0]) + __uint_as_float(rr[1]); }
    if (hi == 0) wsf[32 + r32] = l_reg;
    asm volatile("s_waitcnt lgkmcnt(0)" ::: "memory");
    float rli[16];
#pragma unroll
    for (int r = 0; r < 16; ++r) rli[r] = __builtin_amdgcn_rcpf(wsf[32 + crow(r, hi)]);
    { LAS bf16* stg = (LAS bf16*)(lds + LOST) + wid * 2048;
#pragma unroll
      for (int r = 0; r < 16; ++r) { const int orow = crow(r, hi);
#pragma unroll
          for (int d0 = 0; d0 < 2; ++d0) stg[orow * 64 + d0 * 32 + r32] = (bf16)(cvtpk(o[d0][r] * rli[r], 0.f) & 0xffffu); }
      asm volatile("s_waitcnt lgkmcnt(0)" ::: "memory");
#pragma unroll
      for (int i = 0; i < 4; ++i) { const int row = i * 8 + (lane >> 3), ch = lane & 7; const u32x4 v = *(const LAS u32x4*)(stg + row * 64 + ch * 8); *(u32x4*)(Ow + (size_t)row * D + ch * 8) = v; } }
    __builtin_amdgcn_s_setprio(0);
    asm volatile("s_waitcnt lgkmcnt(0)\n\ts_barrier" ::: "memory");
#undef ATT_TILE
#undef ATT_DMA
#undef ATT_WAIT_BAR
#undef ATT_QK
}
#undef ATT_SBAR
}

__device__ __forceinline__ void row_load(const float* src, int lane, f32x4 (&v)[8]) {
#pragma unroll
    for (int j = 0; j < 8; ++j) v[j] = *(const f32x4*)(src + 4 * lane + 256 * j);
}
__device__ __forceinline__ void row_load_bf(const bf16* src, int lane, f32x4 (&v)[8]) {
#pragma unroll
    for (int j = 0; j < 8; ++j) { const u32x2 w = *(const u32x2*)(src + 4 * lane + 256 * j); v[j] = (f32x4){bf_lo(w.x), bf_hi(w.x), bf_lo(w.y), bf_hi(w.y)}; }
}
__device__ __forceinline__ float row_ssq(const f32x4 (&v)[8]) {
    float s = 0.f;
#pragma unroll
    for (int j = 0; j < 8; ++j) s += (v[j][0] * v[j][0] + v[j][1] * v[j][1]) + (v[j][2] * v[j][2] + v[j][3] * v[j][3]);
    return wave_sum(s);
}
__device__ __forceinline__ void row_norm_mod(f32x4 (&v)[8], int lane, const float* g, const float* sh, const float* sc, bf16* dst) {
    const float rstd = rsqrtf(row_ssq(v) * (1.0f / D) + EPS);
#pragma unroll
    for (int j = 0; j < 8; ++j) { const int c = 4 * lane + 256 * j; const f32x4 gg = *(const f32x4*)(g + c), s1 = *(const f32x4*)(sc + c), s0 = *(const f32x4*)(sh + c);
        v[j] = v[j] * rstd * gg * (s1 + 1.0f) + s0; *(u32x2*)(dst + c) = pack4(v[j]); }
}

template <class RowMap>
__device__ __forceinline__ void transpose_item(const float* W, int N, const float* gk, bf16* WT, int ldk, int kdst0, LAS float* scr, int kb, int nb, int lane, const RowMap& rmap) {
    const int k0 = 64 * kb, n0 = 32 * nb;
    float wv[32];
    { const float* src = W + (size_t)(k0 + (lane >> 5)) * N + n0 + (lane & 31);
#pragma unroll
      for (int i = 0; i < 32; ++i) wv[i] = src[(size_t)(2 * i) * N]; }
    if (gk) { const float* gs = gk + k0 + (lane >> 5);
#pragma unroll
      for (int i = 0; i < 32; ++i) wv[i] *= gs[2 * i]; }
#pragma unroll
    for (int i = 0; i < 32; ++i) scr[(2 * i + (lane >> 5)) * 33 + (lane & 31)] = wv[i];
    asm volatile("s_waitcnt lgkmcnt(0)" ::: "memory");
    const int c = lane & 7;
#pragma unroll
    for (int j = 0; j < 4; ++j) { const int n = (lane >> 3) + 8 * j; const LAS float* s = scr + (8 * c) * 33 + n;
        u32x4 o; o.x = cvtpk(s[0 * 33], s[1 * 33]); o.y = cvtpk(s[2 * 33], s[3 * 33]); o.z = cvtpk(s[4 * 33], s[5 * 33]); o.w = cvtpk(s[6 * 33], s[7 * 33]);
        *(u32x4*)(WT + (size_t)rmap(n0 + n) * ldk + kdst0 + k0 + 8 * c) = o; }
    asm volatile("s_waitcnt lgkmcnt(0)" ::: "memory");
}
struct MapInMain { __device__ __forceinline__ int operator()(int s) const {
    if (s < 1536) return s;
    if (s < 2176) { const int q = s - 1536, head = q >> 6, i = q & 63, sh = i >> 5, ii = i & 31; return 1536 + head * 64 + 8 * (ii >> 2) + 4 * sh + (ii & 3); }
    if (s < 2304) return s;
    if (s < 3328) return s - 512;
    if (s < 3584) return s - 512;
    { const int i = s - 3584, sh = i >> 4, ii = i & 15; return 3072 + 8 * (ii >> 2) + 4 * sh + (ii & 3); } } };
struct MapUq { __device__ __forceinline__ int operator()(int s) const { const int head = s / 96, w = s - head * 96; if (w < 64) return s; const int i = w - 64, sh = i >> 4, ii = i & 15; return head * 96 + 64 + 8 * (ii >> 2) + 4 * sh + (ii & 3); } };
struct MapOff { int off; __device__ __forceinline__ int operator()(int s) const { return off + s; } };
struct MapGU { int off; __device__ __forceinline__ int operator()(int s) const { return ((s >> 7) << 8) + off + (s & 127); } };
#ifndef PROBE_DUP
#define PROBE_DUP 0
#endif
__device__ __forceinline__ int wave_isum(int v) {
#pragma unroll
    for (int o = 1; o < 64; o <<= 1) v += __shfl_xor(v, o);
    return v;
}
__device__ __forceinline__ int block_isum(int v, LAS int* red, int slot, int wave, int lane) {
    const int w = wave_isum(v);
    if (lane == 0) red[slot * 8 + wave] = w;
    __syncthreads();
    int s = 0;
#pragma unroll
    for (int i = 0; i < 8; ++i) s += red[slot * 8 + i];
    return s;
}
__device__ __forceinline__ int block_exscan(int v, LAS int* red, int slot, int wave, int lane) {
    int inc = v;
#pragma unroll
    for (int o = 1; o < 64; o <<= 1) { const int y = __shfl_up(inc, o); if (lane >= o) inc += y; }
    if (lane == 63) red[slot * 8 + wave] = inc;
    __syncthreads();
    int base = 0;
#pragma unroll
    for (int i = 0; i < 8; ++i) base += (i < wave) ? red[slot * 8 + i] : 0;
    return base + inc - v;
}

__device__ __forceinline__ void topk_task(LAS int* red, int set, int e, const float* AFF, int* TOK, int* POS) {
    const int tid = threadIdx.x, lane = tid & 63, wave = tid >> 6;
    const bool lat = set < 4; const int N = lat ? SEQ : CTXL, cap = lat ? CAPL : CAPC, tok0 = lat ? set * SEQ : TL + (set - 4) * CTXL;
    const int rowbase = e * EROWS + (lat ? set * CAPL : NB * CAPL + (set - 4) * CAPC);
    unsigned u[8];
#pragma unroll
    for (int i = 0; i < 8; ++i) { const int idx = tid * 8 + i; u[i] = idx < N ? __float_as_uint(AFF[(size_t)(tok0 + idx) * 16 + e]) + 1u : 0u; }
    unsigned lo = 1u, hi = 0x7f800002u; int it = 0;
    while (hi - lo > 1u) { const unsigned mid = lo + ((hi - lo) >> 1); int c = 0;
#pragma unroll
        for (int i = 0; i < 8; ++i) c += (u[i] >= mid) ? 1 : 0;
        const int tot = block_isum(c, red, it & 1, wave, lane); ++it;
        if (tot >= cap) lo = mid; else hi = mid; }
    const unsigned Tv = lo; int ngt = 0, neq = 0;
#pragma unroll
    for (int i = 0; i < 8; ++i) { ngt += (u[i] > Tv) ? 1 : 0; neq += (u[i] == Tv) ? 1 : 0; }
    const int cgt = block_isum(ngt, red, it & 1, wave, lane); ++it;
    const int need = cap - cgt;
    int eqb = block_exscan(neq, red, it & 1, wave, lane); ++it;
    int nsel = 0; bool sel[8];
#pragma unroll
    for (int i = 0; i < 8; ++i) { sel[i] = (u[i] > Tv) || (u[i] == Tv && eqb < need); if (u[i] == Tv) ++eqb; nsel += sel[i] ? 1 : 0; }
    int slot = block_exscan(nsel, red, it & 1, wave, lane); ++it;
#pragma unroll
    for (int i = 0; i < 8; ++i) { const int idx = tid * 8 + i; if (idx < N) { int p = -1; if (sel[i]) { p = rowbase + slot; ++slot; TOK[p] = tok0 + idx; } POS[(size_t)(tok0 + idx) * 16 + e] = p; } }
    __syncthreads();
}

struct Args { const float* in[22]; float* out; unsigned char* ws; };
enum { I_X = 0, I_C, I_CTX, I_CCTX, I_ADAW, I_ADAB, I_N1G, I_N2G, I_WIN, I_CONVW, I_SINK, I_QNG, I_WUQ, I_KVNG, I_WUKV, I_ONG, I_WOUT, I_WR, I_WG, I_WU, I_WD, I_FNG };

constexpr int MOE_PER_LAYER = 3 * NE * 2048, MOE_SLACK_ITEMS = MOE_PER_LAYER;
constexpr int MOE_P0_SHARE_L = MOE_PER_LAYER - MOE_SLACK_ITEMS;
struct MoeIt { const float* src; bf16* dst; int which; };
__device__ __forceinline__ MoeIt moe_item(unsigned char* ws, LAS unsigned char* lds, int g, int lane) {
    const int l = g / (3 * NE * 2048); int r = g - l * (3 * NE * 2048); const int which = r / (NE * 2048); r -= which * (NE * 2048); const int e = r >> 11; r &= 2047; const int kb = r >> 6, nb = r & 63;
    const float* base = which == 0 ? IN(I_WG) : which == 1 ? IN(I_WU) : IN(I_WD);
    MoeIt m; m.which = which;
    m.src = base + ((size_t)(l * NE + e) * D + 64 * kb + (lane >> 3)) * FF + 32 * nb + 4 * (lane & 7);
    bf16* d = which < 2 ? (bf16*)(ws + WS_WGU) + (size_t)(l * NE + e) * 2 * FF * D : (bf16*)(ws + WS_WD) + (size_t)(l * NE + e) * D * FF;
    const int c = lane & 7, n = 32 * nb + (lane >> 3);
    const int row = which < 2 ? ((n >> 7) << 8) + which * 128 + (n & 127) : n;
    m.dst = d + (size_t)row * D + 64 * kb + 8 * c; return m;
}
constexpr int MOE_SLOT = 8 * 1040, MOE_WAVE_LDS = 2 * MOE_SLOT;
__device__ __forceinline__ void moe_dma(const MoeIt& m, unsigned slot_lds, int lane) {
    const float* s = m.src;
#pragma unroll
    for (int i = 0; i < 8; ++i) att::glds16(s + (size_t)(8 * i) * FF, (unsigned)__builtin_amdgcn_readfirstlane(slot_lds + i * 1040));
}
template <bool STORE = true> __device__ __forceinline__ void moe_finish(const MoeIt& m, LAS const float* slot, int lane) {
    const int c = lane & 7;
#pragma unroll
    for (int j = 0; j < 4; ++j) { const int n = (lane >> 3) + 8 * j; const LAS float* s = slot + c * 260 + n;
        u32x4 o; o.x = cvtpk(s[0], s[32]); o.y = cvtpk(s[64], s[96]); o.z = cvtpk(s[128], s[160]); o.w = cvtpk(s[192], s[224]);
        if (STORE) *(u32x4*)(m.dst + (size_t)(8 * j) * D) = o; else asm volatile("" :: "v"(o)); }
}
template <bool STORE = true> __device__ __forceinline__ void moe_convert(unsigned char* ws, LAS unsigned char* lds, int first, int stride, int end, int wave, int lane) {
    LAS unsigned char* base = lds + wave * MOE_WAVE_LDS; const unsigned b0 = (unsigned)(uintptr_t)base;
    int g = first; if (g >= end) return;
    MoeIt ma = moe_item(ws, lds, g, lane), mb = ma; moe_dma(ma, b0, lane);
    { int gn = g + stride;
      if (gn < end) { mb = moe_item(ws, lds, gn, lane); moe_dma(mb, b0 + MOE_SLOT, lane); asm volatile("s_waitcnt vmcnt(8)" ::: "memory"); } else asm volatile("s_waitcnt vmcnt(0)" ::: "memory");
      moe_finish<STORE>(ma, (LAS const float*)base, lane); asm volatile("s_waitcnt lgkmcnt(0)" ::: "memory");
      if (gn >= end) { asm volatile("s_waitcnt vmcnt(0)" ::: "memory"); return; } g = gn; }
    for (;;) {
        int gn = g + stride;
        if (gn < end) { ma = moe_item(ws, lds, gn, lane); moe_dma(ma, b0, lane); asm volatile("s_waitcnt vmcnt(12)" ::: "memory"); } else asm volatile("s_waitcnt vmcnt(0)" ::: "memory");
        moe_finish<STORE>(mb, (LAS const float*)(base + MOE_SLOT), lane); asm volatile("s_waitcnt lgkmcnt(0)" ::: "memory");
        if (gn >= end) break; g = gn;
        gn = g + stride;
        if (gn < end) { mb = moe_item(ws, lds, gn, lane); moe_dma(mb, b0 + MOE_SLOT, lane); asm volatile("s_waitcnt vmcnt(12)" ::: "memory"); } else asm volatile("s_waitcnt vmcnt(0)" ::: "memory");
        moe_finish<STORE>(ma, (LAS const float*)base, lane); asm volatile("s_waitcnt lgkmcnt(0)" ::: "memory");
        if (gn >= end) break; g = gn;
    }
    asm volatile("s_waitcnt vmcnt(0)" ::: "memory");
}

__device__ __forceinline__ float bf_el(const u32x4& w, int e) { const unsigned x = w[e >> 1]; return (e & 1) ? bf_hi(x) : bf_lo(x); }
__device__ __forceinline__ void fnet_fold_row(const bf16* g, bf16* o, int lane) {
#pragma unroll
    for (int i = 0; i < 4; ++i) { const int k0 = 8 * (lane + 64 * i);
#pragma unroll
        for (int part = 0; part < 2; ++part) { const bf16* src = g + part * SEQ; const float sg = part ? -1.0f : 1.0f;
            const u32x4 fw = *(const u32x4*)(src + k0), rv = *(const u32x4*)(src + SEQ - k0 - 8);
            float e0 = 0.f; if (k0 > 0) e0 = __uint_as_float((unsigned)src[SEQ - k0] << 16);
            float v[8];
            v[0] = bf_el(fw, 0) + sg * e0;
#pragma unroll
            for (int q = 1; q < 8; ++q) v[q] = bf_el(fw, q) + sg * bf_el(rv, 8 - q);
            if (part == 1 && k0 == 0) v[0] = __uint_as_float((unsigned)g[SEQ / 2] << 16);
            const u32x4 ov = {cvtpk(v[0], v[1]), cvtpk(v[2], v[3]), cvtpk(v[4], v[5]), cvtpk(v[6], v[7])};
            *(u32x4*)(o + part * (SEQ / 2) + k0) = ov; } }
}

__device__ __forceinline__ void p0_prologue(unsigned char* ws, LAS unsigned char* lds, int gw, int NGW, int wave, int lane_) {
    LAS float* scr = (LAS float*)(lds + wave * MOE_WAVE_LDS);
    constexpr int A1 = 32 * 97, A2 = 8 * 24, A3 = 4 * 32, A4 = 32 * 64, PERL = A1 + A2 + A3 + A4;
    constexpr int NZ = 224 + 768 + 1024, NFOLD = 256, NADA = 2 * 48 * ADA_KC;
    int lane = lane_;
#define P0_SPLIT() asm volatile("" : "+v"(lane))
#define P0REP(k) for (int prep_ = 0; prep_ < ((PROBE_DUP == (k)) ? 2 : 1); ++prep_)
    for (int l = 0; l < 2; ++l) moe_convert(ws, lds, l * MOE_PER_LAYER + MOE_SLACK_ITEMS + gw, NGW, (l + 1) * MOE_PER_LAYER, wave, lane);
    __syncthreads();
    P0_SPLIT();
    P0REP(31) for (int it = gw; it < NADA; it += NGW) {
        int r = it; const int l = r / (48 * ADA_KC); r -= l * (48 * ADA_KC); const int jg = r / ADA_KC, kc = r - jg * ADA_KC, k0 = kc * (D / ADA_KC);
        const float* W = IN(I_ADAW) + (size_t)l * D * 6 * D + jg * 256 + lane * 4; const float* cin = IN(I_C); const float* ccin = IN(I_CCTX);
        f32x4 acc[5];
#pragma unroll
        for (int q = 0; q < 5; ++q) acc[q] = (f32x4){0.f, 0.f, 0.f, 0.f};
        for (int sub = 0; sub < D / ADA_KC / 64; ++sub) { float sv[5];
#pragma unroll
            for (int q = 0; q < 5; ++q) { const float cv = q < 4 ? cin[q * D + k0 + sub * 64 + lane] : ccin[k0 + sub * 64 + lane]; sv[q] = silu_f(cv); }
#pragma unroll 8
            for (int kk = 0; kk < 64; ++kk) { const f32x4 w4 = *(const f32x4*)(W + (size_t)(k0 + sub * 64 + kk) * 6 * D);
#pragma unroll
                for (int q = 0; q < 5; ++q) acc[q] += w4 * __shfl(sv[q], kk); } }
        float* MP = (float*)(ws + WS_MODP) + ((size_t)kc * 2 + l) * 5 * 6 * D + jg * 256 + lane * 4;
#pragma unroll
        for (int q = 0; q < 5; ++q) *(f32x4*)(MP + q * 6 * D) = acc[q];
    }
    P0_SPLIT();
    P0REP(32) for (int it = NGW - 1 - gw; it < 2 * NFOLD; it += NGW) {
        int r = it; const int l = r / NFOLD; r -= l * NFOLD; const int kb = r >> 3, g = r & 7, k0 = 64 * kb;
        const float* W = IN(I_WIN) + (size_t)l * D * INC + 2304 + g * 64;
        float w[64];
#pragma unroll
        for (int i = 0; i < 64; ++i) w[i] = W[(size_t)(k0 + i) * INC + lane];
#pragma unroll
        for (int i = 0; i < 64; ++i) scr[i * 64 + (lane ^ i)] = w[i];
        asm volatile("s_waitcnt lgkmcnt(0)" ::: "memory");
#pragma unroll
        for (int c = 0; c < 64; ++c) w[c] = scr[lane * 64 + (c ^ lane)];
        float tc, tsn; sincospif((float)lane * (1.0f / 32.0f), &tsn, &tc); tc *= 0.125f; tsn *= 0.125f;
        bf16* WF = (bf16*)(ws + WS_WIN) + ((size_t)l * (NIN_MAIN + NIN_F) + NIN_MAIN) * D;
        for (int cp = 0; cp < 64; ++cp) { float ac = 0.f, as = 0.f;
#pragma unroll
            for (int c = 0; c < 64; ++c) { const int idx = (c * cp) & 63;
                ac += w[c] * __builtin_bit_cast(float, __builtin_amdgcn_readlane(__builtin_bit_cast(int, tc), idx)); as += w[c] * __builtin_bit_cast(float, __builtin_amdgcn_readlane(__builtin_bit_cast(int, tsn), idx)); }
            WF[(size_t)(g * 64 + cp) * D + k0 + lane] = (bf16)(cvtpk(ac, 0.f) & 0xffffu); WF[(size_t)(512 + g * 64 + cp) * D + k0 + lane] = (bf16)(cvtpk(as, 0.f) & 0xffffu); }
        asm volatile("s_waitcnt lgkmcnt(0)" ::: "memory");
    }
    P0_SPLIT();
    P0REP(33) for (int n = gw; n < SEQ; n += NGW) {
        bf16* row = (bf16*)(ws + WS_DN) + (size_t)n * SEQ;
        for (int j = 0; j < 4; ++j) { const int m0 = (j * 64 + lane) * 8; float c[8], s[8];
#pragma unroll
            for (int q = 0; q < 8; ++q) { const float rv = (float)((n * (m0 + q)) & (SEQ - 1)) * (1.0f / 4096.0f); c[q] = __builtin_amdgcn_cosf(rv) * (1.0f / 64.0f); s[q] = __builtin_amdgcn_sinf(rv) * (-1.0f / 64.0f); }
            if (m0 == 0) s[0] = (n & 1) ? (-1.0f / 64.0f) : (1.0f / 64.0f);
            u32x4 oc = {cvtpk(c[0], c[1]), cvtpk(c[2], c[3]), cvtpk(c[4], c[5]), cvtpk(c[6], c[7])}, os = {cvtpk(s[0], s[1]), cvtpk(s[2], s[3]), cvtpk(s[4], s[5]), cvtpk(s[6], s[7])};
            *(u32x4*)(row + m0) = oc; *(u32x4*)(row + SEQ / 2 + m0) = os; }
    }
    P0_SPLIT();
    P0REP(34) for (int it = gw; it < 2 * PERL; it += NGW) {
        const int l = it / PERL; int r = it - l * PERL;
        bf16* WIN = (bf16*)(ws + WS_WIN) + (size_t)l * (NIN_MAIN + NIN_F) * D; bf16* WUP = (bf16*)(ws + WS_WUP) + (size_t)l * NUP * KUP;
        if (r < A1) { const int kb = r / 97; int nb = r - kb * 97; if (nb >= 72) nb += 16; transpose_item(IN(I_WIN) + (size_t)l * D * INC, INC, nullptr, WIN, D, 0, scr, kb, nb, lane, MapInMain{}); continue; } r -= A1;
        if (r < A2) { transpose_item(IN(I_WUQ) + (size_t)l * 512 * 768, 768, IN(I_QNG) + l * 512, WUP, 512, 0, scr, r / 24, r % 24, lane, MapUq{}); continue; } r -= A2;
        if (r < A3) { transpose_item(IN(I_WUKV) + (size_t)l * 256 * 1024, 1024, IN(I_KVNG) + l * 256, WUP + 768 * 512, 256, 0, scr, r / 32, r % 32, lane, MapOff{0}); continue; } r -= A3;
        transpose_item(IN(I_WOUT) + (size_t)l * D * D, D, IN(I_ONG) + l * D, (bf16*)(ws + WS_WO) + (size_t)l * D * D, D, 0, scr, r / 64, r % 64, lane, MapOff{0});
    }
    P0_SPLIT();
    for (int it = gw; it < 2 * NZ; it += NGW) {
        int r = it; const int l = r / NZ; r -= l * NZ;
        bf16* WIN = (bf16*)(ws + WS_WIN) + (size_t)l * (NIN_MAIN + NIN_F) * D; bf16* WUP = (bf16*)(ws + WS_WUP) + (size_t)l * NUP * KUP;
        const u32x4 z = {0u, 0u, 0u, 0u};
        if (r < 224) { u32x4* p = (u32x4*)(WIN + (size_t)(3104 + r) * D);
#pragma unroll
            for (int j = 0; j < 4; ++j) p[lane + 64 * j] = z; }
        (void)WUP;
    }
    P0_SPLIT();
    for (int n = gw; n < SEQ; n += NGW) {
        const int prow = n >> 6, pcol = n & 63;
        if (lane < 48) { const bool sw = lane < 32; const int i = sw ? lane : lane - 32, nf = sw ? 16 : 8; const int j = i < nf ? i : i - nf; const float pos = i < nf ? (float)prow : (float)pcol;
            const float ang = pos * powf(10000.0f, -(float)j / (float)nf); f32x2 cs = {cosf(ang), sinf(ang)};
            if (sw) ((f32x2*)(ws + WS_ROPS))[n * 32 + i] = cs; else ((f32x2*)(ws + WS_ROPM))[n * 16 + i] = cs; }
    }
    P0_SPLIT();
    for (int k = gw; k < CTXL; k += NGW) { bf16* rowl = (bf16*)(ws + WS_DL) + (size_t)k * 2 * CTXL; const int m0 = lane * 8; float cv[8];
#pragma unroll
        for (int q = 0; q < 8; ++q) { const int m = m0 + q, rr = (k * (m & 255)) & 255; float s, cc; sincospif((float)rr * (1.0f / 128.0f), &s, &cc); cv[q] = (m < 256 ? cc : -s) * (1.0f / 16.0f); }
        u32x4 ov = {cvtpk(cv[0], cv[1]), cvtpk(cv[2], cv[3]), cvtpk(cv[4], cv[5]), cvtpk(cv[6], cv[7])}; *(u32x4*)(rowl + m0) = ov; }
#undef P0_SPLIT
#undef P0REP
}
#ifndef PROBE_DUP
#define PROBE_DUP 0
#endif
#ifndef MIX_S0
#define MIX_S0 3
#endif
#ifndef MOE_C0
#define MOE_C0 4
#endif
#define REP(k) for (int rep_ = 0; rep_ < ((PROBE_DUP == (k)) ? 2 : 1); ++rep_)
__global__ void __launch_bounds__(NTHR, 2) mega_fwd(Args args) {
    extern __shared__ __attribute__((aligned(16))) unsigned char lds_raw[];
    LAS unsigned char* lds = (LAS unsigned char*)lds_raw;
    const int tid0 = threadIdx.x, wave = __builtin_amdgcn_readfirstlane(tid0 >> 6);
    int tid = tid0, lane = tid0 & 63;
#define MODL (MOD + (size_t)l * 5 * 6 * D)
#define WINl ((const char*)(ws + WS_WIN) + (size_t)l * (NIN_MAIN + NIN_F) * D * 2)
#define LAUNDER() do { tid = threadIdx.x; asm volatile("" : "+v"(tid)); lane = tid & 63; unsigned long long w_ = (unsigned long long)args.ws; asm volatile("" : "+s"(w_)); ws = (unsigned char*)(GAS unsigned char*)w_; } while (0)
    const int G = gridDim.x, c = blockIdx.x, gw = c * NWAVES + wave, NGW = G * NWAVES;
    volatile LAS unsigned* MISC = (volatile LAS unsigned*)(lds + LDS_MISC);
    if (tid < 64) MISC[tid] = 0u;
    if (tid == 0) { LAS unsigned long long* at = (LAS unsigned long long*)(lds + LDS_ARGS);
#pragma unroll
        for (int i = 0; i < 22; ++i) at[i] = (unsigned long long)args.in[i];
        at[22] = (unsigned long long)args.out; }
    __syncthreads();
    unsigned char* ws = args.ws;
    (void)xcd_barrier_post((unsigned*)(ws + WS_CTL) + CW_BAR, MISC + 8);
#define GRID_BAR() do { XcdBarrier b_; b_.bar = (unsigned*)(args.ws + WS_CTL) + CW_BAR; b_.x = xb_xcc_id(); b_.st = (volatile LAS unsigned*)(lds + LDS_MISC) + 8; xcd_barrier(b_); } while (0)
#define MOD ((const float*)(ws + CTL_MOD))
#define X ((bf16*)(ws + WS_X))
#define H ((bf16*)(ws + WS_H))
#define PC ((bf16*)(ws + WS_PC))
#define SQ ((bf16*)(ws + WS_SQ))
#define KS ((bf16*)(ws + WS_KS))
#define VS ((bf16*)(ws + WS_VS))
#define MCQ ((bf16*)(ws + WS_MCQ))
#define QM ((bf16*)(ws + WS_QM))
#define KM ((bf16*)(ws + WS_KM))
#define VM ((bf16*)(ws + WS_VM))
#define GT ((bf16*)(ws + WS_GT))
#define GTC ((bf16*)(ws + WS_GTC))
#define YMIX ((bf16*)(ws + WS_YMIX))
#define SSQ ((float*)(ws + WS_SSQ))
#define AFF ((float*)(ws + WS_AFF))
#define POS ((int*)(ws + WS_POS))
#define TOK ((int*)(ws + WS_TOK))
#define ACT ((bf16*)(ws + WS_ACT))
#define Y ((bf16*)(ws + WS_Y))
#define ROPS ((const f32x2*)(ws + WS_ROPS))
#define ROPM ((const f32x2*)(ws + WS_ROPM))

    LAUNDER();
    p0_prologue(ws, lds, gw, NGW, wave, lane);
    GRID_BAR();
#if PROBE_DUP == 1
    LAUNDER(); p0_prologue(ws, lds, gw, NGW, wave, lane);
    GRID_BAR();
#endif
#if PROBE_DUP == 20
    for (int q = 0; q < 10; ++q) GRID_BAR();
#endif
#if PROBE_DUP == 18
    LAUNDER(); if ((c & 3) == 0) moe_convert(ws, lds, (c >> 2) * NWAVES + wave, 64 * NWAVES, 64 * NWAVES * 40, wave, lane);
    GRID_BAR();
#endif
#if PROBE_DUP == 19
    LAUNDER(); if ((c & 15) == 0) moe_convert(ws, lds, (c >> 4) * NWAVES + wave, 16 * NWAVES, 16 * NWAVES * 40, wave, lane);
    GRID_BAR();
#endif
    LAUNDER();
    for (int i = c * NTHR + tid; i < 2 * 5 * 6 * D; i += G * NTHR) { const int l = i / (5 * 6 * D), j = i % (6 * D); float s = IN(I_ADAB)[l * 6 * D + j];
#pragma unroll
        for (int kc = 0; kc < ADA_KC; ++kc) s += ((const float*)(ws + WS_MODP))[(size_t)kc * 2 * 5 * 6 * D + i];
        ((float*)(ws + CTL_MOD))[i] = s; }
    GRID_BAR();
    LAUNDER();
    REP(14) for (int t0 = gw; t0 < T; t0 += 2 * NGW) { const int t1 = (t0 + NGW < T) ? t0 + NGW : t0; f32x4 v0[8], v1[8];
        row_load(t0 < TL ? IN(I_X) + (size_t)t0 * D : IN(I_CTX) + (size_t)(t0 - TL) * D, lane, v0); row_load(t1 < TL ? IN(I_X) + (size_t)t1 * D : IN(I_CTX) + (size_t)(t1 - TL) * D, lane, v1);
        const float* m0 = MOD + mod_row(t0) * 6 * D; const float* m1 = MOD + mod_row(t1) * 6 * D;
        row_norm_mod(v0, lane, IN(I_N1G), m0, m0 + D, H + (size_t)t0 * D); row_norm_mod(v1, lane, IN(I_N1G), m1, m1 + D, H + (size_t)t1 * D); }
    GRID_BAR();

    for (int l = 0; l < 2; ++l) {
        const bool last = (l == 1); const int rows = last ? TL : T;
        LAUNDER();
        REP(2) { SchedInproj S{(const char*)H, WINl, WINl + (size_t)NIN_MAIN * D * 2, G, c}; EpiInproj E{ws};
          pg8::gemm_phase<false>(lds, D, D * 2, D * 2, S, E);
        GRID_BAR(); }
        LAUNDER();
        REP(3) { int cq = c; asm volatile("" : "+s"(cq)); const char* wupl = (const char*)(ws + WS_WUP) + (size_t)l * NUP * KUP * 2; EpiUp E{ws};
          { SchedPlain S{(const char*)MCQ, wupl, 68, 3, G, cq, KUP * 2, 512 * 2, 0}; pg8::gemm_phase<false>(lds, 512, KUP * 2, 512 * 2, S, E); }
          { const int cr = (cq + G - (204 % G)) % G;
            SchedPlain S{(const char*)(MCQ + 512), wupl + (size_t)768 * 512 * 2, 68, 4, G, cr, KUP * 2, 256 * 2, 1}; pg8::gemm_phase<false>(lds, 256, KUP * 2, 256 * 2, S, E); }
          LAUNDER();
          for (int task = gw; task < NB * 512; task += NGW) fnet_fold_row(GT + (size_t)task * 2 * SEQ, (bf16*)(ws + WS_GTF) + (size_t)task * SEQ, lane);
        GRID_BAR(); }
        LAUNDER();
        REP(4) {
        if (!last) { SchedFnetC S{(const char*)(ws + WS_DL), (const char*)GTC, c, G}; EpiFnetC E{YMIX}; pg8::gemm_phase<false>(lds, 2 * CTXL, 2 * CTXL * 2, 2 * CTXL * 2, S, E); }
        REP(11) { SchedFnet S{(const char*)(ws + WS_DN), (const char*)(ws + WS_GTF), c, G}; EpiFnet E{YMIX}; pg8::gemm_phase<false>(lds, SEQ, SEQ * 2, SEQ * 2, S, E); }
        {
            int cx = c; asm volatile("" : "+s"(cx));
            const bool tuned = (G == 256); const int x = cx & 7, li = cx >> 3; const int cls = tuned ? (li < 16 ? 0 : li < 24 ? 1 : 2) : 0;
            const int mbase = l * MOE_PER_LAYER, n0i = 1024 * MOE_C0, n12 = (MOE_PER_LAYER - n0i) / 2;
            if (tuned && cls == 1) { moe_convert(ws, lds, mbase + n0i + ((x * 8 + li - 16) * NWAVES + wave), 64 * NWAVES, mbase + n0i + n12, wave, lane); __syncthreads(); }
            const int nm = tuned ? 2 : (512 - c + G - 1) / G; const int kb = (li < 16) ? 2 * li : 32 + 2 * (li - 16);
            REP(12) for (int i = 0; i < nm; ++i) { const int k = kb + i; const int id = tuned ? (4 * x + (k >> 4)) * 16 + (k & 15) : c + i * G; if (id >= 512) break;
                const int bh = id >> 4, qb = id & 15, b = bh >> 3, h = bh & 7; const size_t r0 = (size_t)b * SEQ + qb * 256 + wave * 32;
                att::attn_unit<96, false>(lds, QM + r0 * 768 + h * 96, 768, KM + (size_t)b * KVR * 512 + h * 64, 512, (const bf16*)(ws + WS_KPE) + (size_t)b * KVR * 32, VM + (size_t)b * KVR * 512 + h * 64, 512, YMIX + r0 * D + 1536 + h * 64, 0, 64, 4, 0, -1e30f, 0.f); }
            const int ns = tuned ? (li < 16 ? MIX_S0 : 4 - MIX_S0) : (512 - c + G - 1) / G; const int sb = li < 16 ? MIX_S0 * li : 16 * MIX_S0 + (4 - MIX_S0) * (li - 16);
            REP(13) for (int i = 0; i < ns; ++i) { const int k = sb + i; const int id = tuned ? (4 * x + (k >> 4)) * 16 + (k & 15) : c + i * G; if (id >= 512) break;
                const int bh = id >> 4, qb = id & 15, b = bh >> 3, h = bh & 7; const size_t r0 = (size_t)b * SEQ + qb * 256 + wave * 32;
                const int a0 = (4 * qb - 2) < 0 ? 0 : 4 * qb - 2, a1 = (4 * qb + 6) > 64 ? 64 : 4 * qb + 6;
                att::attn_unit<64, true>(lds, SQ + r0 * 512 + h * 64, 512, KS + (size_t)b * KVR * 128 + (h >> 2) * 64, 128, nullptr, VS + (size_t)b * KVR * 128 + (h >> 2) * 64, 128, YMIX + r0 * D + 512 + h * 64,
                                         a0, a1 - a0, 4, qb * 256, IN(I_SINK)[l * 8 + h] * LOG2E, 1.f); }
            if (!last) {
                const int nc = tuned ? (li < 8 ? 1 : 0) : (64 - c + G - 1) / G;
                REP(23) for (int i = 0; i < nc; ++i) { const int id = tuned ? x * 8 + li : c + i * G; if (id >= 64) break;
                    const int bh = id & 31, b = bh >> 3, h = bh & 7; const size_t r0 = (size_t)TL + b * CTXL + wave * 32;
                    if (id < 32) att::attn_unit<96, false>(lds, QM + r0 * 768 + h * 96, 768, KM + (size_t)b * KVR * 512 + h * 64, 512, (const bf16*)(ws + WS_KPE) + (size_t)b * KVR * 32, VM + (size_t)b * KVR * 512 + h * 64, 512, YMIX + r0 * D + 1536 + h * 64, 0, 0, 4, 0, -1e30f, 0.f);
                    else att::attn_unit<64, false>(lds, SQ + r0 * 512 + h * 64, 512, KS + (size_t)b * KVR * 128 + (h >> 2) * 64, 128, nullptr, VS + (size_t)b * KVR * 128 + (h >> 2) * 64, 128, YMIX + r0 * D + 512 + h * 64,
                                                   0, 0, 4, 0, IN(I_SINK)[l * 8 + h] * LOG2E, 1.f); } }
            LAUNDER();
            if (!tuned) moe_convert(ws, lds, mbase + gw, NGW, mbase + MOE_PER_LAYER, wave, lane);
            else if (cls == 0) moe_convert(ws, lds, mbase + ((x * 16 + li) * NWAVES + wave), 128 * NWAVES, mbase + n0i, wave, lane);
            else if (cls == 2) moe_convert(ws, lds, mbase + n0i + n12 + ((x * 8 + li - 24) * NWAVES + wave), 64 * NWAVES, mbase + MOE_PER_LAYER, wave, lane);
        }
        __syncthreads();
        LAUNDER();
        {
            const float* cw = IN(I_CONVW) + l * 3 * 512;
            const bool cv0 = (G == 256); const int t0c = cv0 ? (((c >> 3) < 16) ? ((c & 7) * 16 + (c >> 3)) * NWAVES + wave : rows) : gw, tsc = cv0 ? 128 * NWAVES : NGW;
            REP(21) for (int t = t0c; t < rows; t += tsc) { int pos, len; if (t < TL) { pos = t & (SEQ - 1); len = SEQ; } else { pos = (t - TL) & (CTXL - 1); len = CTXL; }
                const bf16* pr = PC + (size_t)t * 1536 + 8 * lane; float y[8];
                const u32x4 cb = *(const u32x4*)pr, cc = *(const u32x4*)(pr + 512), ch = *(const u32x4*)(pr + 1024);
                const f32x4 w1a = *(const f32x4*)(cw + 512 + 8 * lane), w1b = *(const f32x4*)(cw + 512 + 8 * lane + 4);
#pragma unroll
                for (int q = 0; q < 4; ++q) { y[2 * q] = bf_lo(cc[q]) * bf_lo(ch[q]) * (q < 2 ? w1a[2 * q] : w1b[2 * q - 4]); y[2 * q + 1] = bf_hi(cc[q]) * bf_hi(ch[q]) * (q < 2 ? w1a[2 * q + 1] : w1b[2 * q - 3]); }
                if (pos > 0) { const u32x4 c2 = *(const u32x4*)(pr - 1536 + 512), h2 = *(const u32x4*)(pr - 1536 + 1024); const f32x4 wa = *(const f32x4*)(cw + 8 * lane), wb = *(const f32x4*)(cw + 8 * lane + 4);
#pragma unroll
                    for (int q = 0; q < 4; ++q) { y[2 * q] += bf_lo(c2[q]) * bf_lo(h2[q]) * (q < 2 ? wa[2 * q] : wb[2 * q - 4]); y[2 * q + 1] += bf_hi(c2[q]) * bf_hi(h2[q]) * (q < 2 ? wa[2 * q + 1] : wb[2 * q - 3]); } }
                if (pos < len - 1) { const u32x4 c2 = *(const u32x4*)(pr + 1536 + 512), h2 = *(const u32x4*)(pr + 1536 + 1024); const f32x4 wa = *(const f32x4*)(cw + 1024 + 8 * lane), wb = *(const f32x4*)(cw + 1024 + 8 * lane + 4);
#pragma unroll
                    for (int q = 0; q < 4; ++q) { y[2 * q] += bf_lo(c2[q]) * bf_lo(h2[q]) * (q < 2 ? wa[2 * q] : wb[2 * q - 4]); y[2 * q + 1] += bf_hi(c2[q]) * bf_hi(h2[q]) * (q < 2 ? wa[2 * q + 1] : wb[2 * q - 3]); } }
                u32x4 o;
#pragma unroll
                for (int q = 0; q < 4; ++q) o[q] = cvtpk(bf_lo(cb[q]) * y[2 * q], bf_hi(cb[q]) * y[2 * q + 1]);
                *(u32x4*)(YMIX + (size_t)t * D + 8 * lane) = o; }
        }
        LAUNDER();
        GRID_BAR(); }
        LAUNDER();
        for (int t0 = gw; t0 < rows; t0 += 2 * NGW) { const int t1 = (t0 + NGW < rows) ? t0 + NGW : t0; bf16* y0 = YMIX + (size_t)t0 * D + 8 * lane; bf16* y1 = YMIX + (size_t)t1 * D + 8 * lane;
            u32x4 va[4], vb[4];
#pragma unroll
            for (int g = 0; g < 4; ++g) { va[g] = *(const u32x4*)(y0 + 512 * g); vb[g] = *(const u32x4*)(y1 + 512 * g); }
#pragma unroll
            for (int g = 0; g < 4; ++g) { float fa[8], fb[8]; float sa = 0.f, sb = 0.f;
#pragma unroll
                for (int q = 0; q < 4; ++q) { fa[2 * q] = bf_lo(va[g][q]); fa[2 * q + 1] = bf_hi(va[g][q]); sa += fa[2 * q] * fa[2 * q] + fa[2 * q + 1] * fa[2 * q + 1];
                                              fb[2 * q] = bf_lo(vb[g][q]); fb[2 * q + 1] = bf_hi(vb[g][q]); sb += fb[2 * q] * fb[2 * q] + fb[2 * q + 1] * fb[2 * q + 1]; }
                const float ra = rsqrtf(wave_sum(sa) * (1.0f / 512.0f) + EPS), rb = rsqrtf(wave_sum(sb) * (1.0f / 512.0f) + EPS); u32x4 oa, ob;
#pragma unroll
                for (int q = 0; q < 4; ++q) { oa[q] = cvtpk(fa[2 * q] * ra, fa[2 * q + 1] * ra); ob[q] = cvtpk(fb[2 * q] * rb, fb[2 * q + 1] * rb); }
                *(u32x4*)(y0 + 512 * g) = oa; if (t1 != t0) *(u32x4*)(y1 + 512 * g) = ob; } }
        GRID_BAR();
        LAUNDER();
        for (int rep5 = 0; rep5 < ((PROBE_DUP == 5 && l == 0) ? 2 : 1); ++rep5) { SchedPlain S{(const char*)YMIX, (const char*)(ws + WS_WO) + (size_t)l * D * D * 2, rows / 256, 8, G, c, D * 2, D * 2, 0};
          EpiOut E{IN(I_X), IN(I_CTX), l == 0 ? (const bf16*)nullptr : (const bf16*)X, X, MODL};
          pg8::gemm_phase<false>(lds, D, D * 2, D * 2, S, E);
        GRID_BAR(); }
        LAUNDER();
        REP(6) {
        { LAS float* WT = (LAS float*)lds; const float* wr = IN(I_WR) + (size_t)l * D * 16;
          for (int i = tid; i < D * 4; i += NTHR) { const int k = i >> 2, q = i & 3; const f32x4 w = *(const f32x4*)(wr + k * 16 + q * 4);
              WT[(4 * q + 0) * D + k] = w[0]; WT[(4 * q + 1) * D + k] = w[1]; WT[(4 * q + 2) * D + k] = w[2]; WT[(4 * q + 3) * D + k] = w[3]; }
          __syncthreads();
          for (int t0 = gw; t0 < rows; t0 += 2 * NGW) { const int t1 = (t0 + NGW < rows) ? t0 + NGW : t0; f32x4 v0[8], v1[8];
              row_load_bf(X + (size_t)t0 * D, lane, v0); row_load_bf(X + (size_t)t1 * D, lane, v1);
              const float* m0 = MODL + mod_row(t0) * 6 * D; const float* m1 = MODL + mod_row(t1) * 6 * D;
              row_norm_mod(v0, lane, IN(I_N2G) + l * D, m0 + 3 * D, m0 + 4 * D, H + (size_t)t0 * D); row_norm_mod(v1, lane, IN(I_N2G) + l * D, m1 + 3 * D, m1 + 4 * D, H + (size_t)t1 * D);
              float lg0[16], lg1[16];
#pragma unroll
              for (int e = 0; e < 16; ++e) { float s0 = 0.f, s1 = 0.f;
#pragma unroll
                  for (int j = 0; j < 8; ++j) { const f32x4 w = *(const LAS f32x4*)(WT + e * D + 4 * lane + 256 * j);
                      s0 += (v0[j][0] * w[0] + v0[j][1] * w[1]) + (v0[j][2] * w[2] + v0[j][3] * w[3]); s1 += (v1[j][0] * w[0] + v1[j][1] * w[1]) + (v1[j][2] * w[2] + v1[j][3] * w[3]); }
                  lg0[e] = wave_sum(s0); lg1[e] = wave_sum(s1); asm volatile("" ::: "memory"); }
              float mx0 = lg0[0], mx1 = lg1[0];
#pragma unroll
              for (int e = 1; e < 16; ++e) { mx0 = fmaxf(mx0, lg0[e]); mx1 = fmaxf(mx1, lg1[e]); }
              float den0 = 0.f, mine0 = 0.f, den1 = 0.f, mine1 = 0.f;
#pragma unroll
              for (int e = 0; e < 16; ++e) { lg0[e] = __expf(lg0[e] - mx0); den0 += lg0[e]; mine0 = (lane == e) ? lg0[e] : mine0; lg1[e] = __expf(lg1[e] - mx1); den1 += lg1[e]; mine1 = (lane == e) ? lg1[e] : mine1; }
              if (lane < 16) { AFF[(size_t)t0 * 16 + lane] = mine0 / den0; if (t1 != t0) AFF[(size_t)t1 * 16 + lane] = mine1 / den1; } }
          __syncthreads(); }
        GRID_BAR(); }
        LAUNDER();
        REP(7) {
        { const int ntask = last ? 64 : 128; for (int task = c; task < ntask; task += G) topk_task((LAS int*)lds, task >> 4, task & 15, AFF, TOK, POS); }
        GRID_BAR(); }
        LAUNDER();
        const int npm = last ? 8 : 9;
        REP(8) {
        { LAS int* tokl = (LAS int*)(lds + LDS_TOK);
          SchedMoe S{(const char*)H, (const char*)(ws + WS_WGU) + (size_t)l * NE * 2 * FF * D * 2, npm, 16, G, c, 0, (size_t)2 * FF * D * 2, D * 2, tokl};
          { pg8::Unit u; for (int i = 0; S.next(i, u); ++i) if (tid < 256) tokl[i * 256 + tid] = TOK[u.aux * EROWS + (u.pm < 8 ? u.pm * 256 + tid : 2048 + (tid & 127))]; }
          __syncthreads();
          EpiGU E{ACT}; pg8::gemm_phase<true>(lds, D, D * 2, D * 2, S, E); }
        GRID_BAR(); }
        LAUNDER();
        REP(9) {
        { SchedMoe S{(const char*)ACT, (const char*)(ws + WS_WD) + (size_t)l * NE * D * FF * 2, npm, 8, G, c, (size_t)EROWS * FF * 2, (size_t)D * FF * 2, FF * 2, nullptr};
          EpiDown E{Y}; pg8::gemm_phase<false>(lds, FF, FF * 2, FF * 2, S, E); }
        GRID_BAR(); }
        LAUNDER();
        REP(15) for (int t0 = gw; t0 < rows; t0 += 2 * NGW) { const int t1 = (t0 + NGW < rows) ? t0 + NGW : t0; const bool two = (t1 != t0);
            bf16* Xw = X; bf16* Hw = H; float* Ow = (float*)IN(22); if (PROBE_DUP == 15 && rep_ == 0) { Xw = (bf16*)(ws + WS_ACT); Hw = (bf16*)(ws + WS_PC); Ow = (float*)(ws + WS_ACT); }
            f32x4 v0[8], v1[8], s0[8], s1[8]; row_load_bf(X + (size_t)t0 * D, lane, v0); row_load_bf(X + (size_t)t1 * D, lane, v1);
            const int pl0 = (lane < 16) ? POS[(size_t)t0 * 16 + lane] : -1, pl1 = (lane < 16) ? POS[(size_t)t1 * 16 + lane] : -1;
            const float al0 = (lane < 16) ? AFF[(size_t)t0 * 16 + lane] : 0.f, al1 = (lane < 16) ? AFF[(size_t)t1 * 16 + lane] : 0.f;
#pragma unroll
            for (int j = 0; j < 8; ++j) { s0[j] = (f32x4){0.f, 0.f, 0.f, 0.f}; s1[j] = (f32x4){0.f, 0.f, 0.f, 0.f}; }
            unsigned long long sel0 = __ballot(pl0 >= 0), sel1 = __ballot(pl1 >= 0);
            while (sel0 | sel1) {
                const bool h0 = sel0 != 0ull, h1 = sel1 != 0ull; const int e0 = h0 ? __builtin_ctzll(sel0) : 0, e1 = h1 ? __builtin_ctzll(sel1) : 0; sel0 &= sel0 - 1; sel1 &= sel1 - 1;
                const int p0 = h0 ? __builtin_amdgcn_readlane(pl0, e0) : 0, p1 = h1 ? __builtin_amdgcn_readlane(pl1, e1) : 0;
                const float a0 = h0 ? __builtin_bit_cast(float, __builtin_amdgcn_readlane(__builtin_bit_cast(int, al0), e0)) : 0.f, a1 = h1 ? __builtin_bit_cast(float, __builtin_amdgcn_readlane(__builtin_bit_cast(int, al1), e1)) : 0.f;
                const bf16* y0 = Y + (size_t)p0 * D + 4 * lane; const bf16* y1 = Y + (size_t)p1 * D + 4 * lane; u32x2 w0[8], w1[8];
#pragma unroll
                for (int j = 0; j < 8; ++j) { w0[j] = *(const u32x2*)(y0 + 256 * j); w1[j] = *(const u32x2*)(y1 + 256 * j); }
#pragma unroll
                for (int j = 0; j < 8; ++j) { s0[j] += (f32x4){bf_lo(w0[j].x), bf_hi(w0[j].x), bf_lo(w0[j].y), bf_hi(w0[j].y)} * a0; s1[j] += (f32x4){bf_lo(w1[j].x), bf_hi(w1[j].x), bf_lo(w1[j].y), bf_hi(w1[j].y)} * a1; } }
            const float* g20 = MODL + mod_row(t0) * 6 * D + 5 * D; const float* g21 = MODL + mod_row(t1) * 6 * D + 5 * D;
#pragma unroll
            for (int j = 0; j < 8; ++j) { v0[j] += *(const f32x4*)(g20 + 4 * lane + 256 * j) * s0[j]; v1[j] += *(const f32x4*)(g21 + 4 * lane + 256 * j) * s1[j]; }
            if (!last) {
#pragma unroll
                for (int j = 0; j < 8; ++j) { *(u32x2*)(Xw + (size_t)t0 * D + 4 * lane + 256 * j) = pack4(v0[j]); if (two) *(u32x2*)(Xw + (size_t)t1 * D + 4 * lane + 256 * j) = pack4(v1[j]); }
                const float* m0 = MOD + (size_t)(l + 1) * 5 * 6 * D + mod_row(t0) * 6 * D; const float* m1 = MOD + (size_t)(l + 1) * 5 * 6 * D + mod_row(t1) * 6 * D;
                row_norm_mod(v0, lane, IN(I_N1G) + (l + 1) * D, m0, m0 + D, Hw + (size_t)t0 * D); row_norm_mod(v1, lane, IN(I_N1G) + (l + 1) * D, m1, m1 + D, Hw + (size_t)t1 * D);
            } else { const float r0 = rsqrtf(row_ssq(v0) * (1.0f / D) + EPS), r1 = rsqrtf(row_ssq(v1) * (1.0f / D) + EPS); float* od = Ow;
#pragma unroll
                for (int j = 0; j < 8; ++j) { const f32x4 fg = *(const f32x4*)(IN(I_FNG) + 4 * lane + 256 * j); *(f32x4*)(od + (size_t)t0 * D + 4 * lane + 256 * j) = v0[j] * r0 * fg; if (two) *(f32x4*)(od + (size_t)t1 * D + 4 * lane + 256 * j) = v1[j] * r1 * fg; } }
        }
        if (!last) GRID_BAR();
    }
}

extern "C" void kernel_launch(void* const* d_in, const int* in_sizes, int n_in, void* d_out, int out_size, void* d_ws, size_t ws_size, hipStream_t stream) {
    static int grid = 0;
    if (grid == 0) {
        if (n_in != 22 || out_size != TL * D || ws_size < WS_END) { fprintf(stderr, "kernel_launch: unexpected problem (n_in %d, out %d, ws %zu < %zu)\n", n_in, out_size, ws_size, (size_t)WS_END); grid = -1; return; }
        int dev = 0, cus = 0, per_cu = 0;
        if (hipGetDevice(&dev) != hipSuccess || hipDeviceGetAttribute(&cus, hipDeviceAttributeMultiprocessorCount, dev) != hipSuccess) { grid = -1; return; }
        if (hipFuncSetAttribute((const void*)mega_fwd, hipFuncAttributeMaxDynamicSharedMemorySize, LDS_BYTES) != hipSuccess) { fprintf(stderr, "kernel_launch: hipFuncSetAttribute failed\n"); grid = -1; return; }
        if (hipOccupancyMaxActiveBlocksPerMultiprocessor(&per_cu, (const void*)mega_fwd, NTHR, LDS_BYTES) != hipSuccess || per_cu < 1) { fprintf(stderr, "kernel_launch: occupancy query reports %d\n", per_cu); (void)hipGetLastError(); grid = -1; return; }
        if (cus < 144) { fprintf(stderr, "kernel_launch: %d CUs: this kernel needs at least 144\n", cus); grid = -1; return; }
        grid = cus;
    }
    if (grid < 0) return;
    if (hipMemsetAsync((char*)d_ws + WS_CTL + (size_t)CW_BAR * 4, 0, (size_t)XCD_BAR_WORDS * 4, stream) != hipSuccess) return;
    Args a{};
    for (int i = 0; i < 22; ++i) a.in[i] = (const float*)d_in[i];
    a.out = (float*)d_out; a.ws = (unsigned char*)d_ws;
    hipLaunchKernelGGL(mega_fwd, dim3(grid), dim3(NTHR), LDS_BYTES, stream, a);
}
```

```cpp
#include <hip/hip_runtime.h>
#include <cstdio>
#include <cstdint>

#define GAS __attribute__((address_space(1)))
#define LAS __attribute__((address_space(3)))
typedef unsigned short bf16;
typedef unsigned u32x4 __attribute__((ext_vector_type(4)));
typedef unsigned u32x2 __attribute__((ext_vector_type(2)));
typedef float f32x4 __attribute__((ext_vector_type(4)));
typedef float f32x2 __attribute__((ext_vector_type(2)));
typedef float f32x16 __attribute__((ext_vector_type(16)));
typedef short bf16x8 __attribute__((ext_vector_type(8)));
typedef short s16x4 __attribute__((ext_vector_type(4)));
typedef __bf16 bf16x2_t __attribute__((ext_vector_type(2)));

constexpr int D = 2048, NB = 4, SEQ = 4096, CTXL = 256;
constexpr int TL = NB * SEQ, TC = NB * CTXL, T = TL + TC;
constexpr int INC = 3616, NE = 16, FF = 2048, CAPL = 512, CAPC = 32;
constexpr int KVR = SEQ + CTXL;
constexpr int EROWS = 2304;
constexpr float EPS = 1e-6f;
constexpr float LOG2E = 1.4426950408889634f;
constexpr float QSC_S = 0.125f * LOG2E;
constexpr float QSC_M = 0.10206207261596575f * LOG2E;
constexpr int NWAVES = 8, NTHR = 512;

__device__ __forceinline__ unsigned cvtpk(float lo, float hi) { f32x2 v = {lo, hi}; bf16x2_t b = __builtin_convertvector(v, bf16x2_t); return __builtin_bit_cast(unsigned, b); }
__device__ __forceinline__ float bf_lo(unsigned w) { return __uint_as_float(w << 16); }
__device__ __forceinline__ float bf_hi(unsigned w) { return __uint_as_float(w & 0xffff0000u); }
__device__ __forceinline__ float wave_sum(float v) {
#pragma unroll
    for (int o = 1; o < 64; o <<= 1) v += __shfl_xor(v, o);
    return v;
}
__device__ __forceinline__ float silu_f(float v) { return v / (1.0f + __expf(-v)); }
__device__ __forceinline__ int mod_row(int t) { return t < TL ? (t >> 12) : 4; }
__device__ __forceinline__ int kv_row(int t) { return t < TL ? (t >> 12) * KVR + (t & (SEQ - 1)) : ((t - TL) >> 8) * KVR + SEQ + ((t - TL) & (CTXL - 1)); }

#define XB_TMO      128
#define XB_XCNT(j)  (256  + 64 * (j))
#define XB_XSUB(j)  (1280 + 64 * (j))
#define XB_XGEN(j)  (2304 + 64 * (j))
#define XB_TOP      3328
#define XB_TOPGEN   3392
#define XCD_BAR_WORDS 3456
#define XB_SPIN_CAP (1u << 18)
__device__ __forceinline__ unsigned xb_ld(unsigned* p)              { return __hip_atomic_load(p, __ATOMIC_RELAXED, __HIP_MEMORY_SCOPE_AGENT); }
__device__ __forceinline__ unsigned xb_add(unsigned* p, unsigned v) { return __hip_atomic_fetch_add(p, v, __ATOMIC_RELAXED, __HIP_MEMORY_SCOPE_AGENT); }
__device__ __forceinline__ unsigned xb_xcc_id() { return (unsigned)__builtin_amdgcn_s_getreg((3 << 11) | 20) & 0xFu; }
#define XB_SPIN(cond, bar) do { unsigned _sp = 0; while (cond) { __builtin_amdgcn_s_sleep(1); \
    if ((++_sp & 255u) == 0u) { if (xb_ld(&(bar)[XB_TMO])) break; if (_sp > XB_SPIN_CAP) { atomicAdd(&(bar)[XB_TMO], 1u); break; } } } } while (0)
struct XcdBarrier { unsigned* bar; unsigned x; volatile LAS unsigned* st; };
__device__ __forceinline__ XcdBarrier xcd_barrier_post(unsigned* bar, volatile LAS unsigned* st) {
    XcdBarrier b; b.bar = bar; b.x = xb_xcc_id(); b.st = st;
    if (threadIdx.x == 0) (void)xb_add(&bar[XB_XCNT(b.x)], 1u);
    return b;
}
__device__ __forceinline__ void xcd_barrier_complete(unsigned* bar, unsigned x, unsigned& nloc, unsigned& nx) {
    const unsigned G = gridDim.x * gridDim.y * gridDim.z;
    unsigned sum, cnt, mine, sp = 0u;
    for (;;) {
        sum = 0u; cnt = 0u; mine = 0u;
#pragma unroll
        for (unsigned j = 0; j < 16; ++j) { const unsigned c = xb_ld(&bar[XB_XCNT(j)]); sum += c; cnt += (c > 0u) ? 1u : 0u; mine = (j == x) ? c : mine; }
        if (sum == G) break;
        __builtin_amdgcn_s_sleep(1);
        if ((++sp & 255u) == 0u) { if (xb_ld(&bar[XB_TMO])) break; if (sp > XB_SPIN_CAP) { atomicAdd(&bar[XB_TMO], 1u); break; } }
    }
    nloc = mine > 0u ? mine : 1u; nx = cnt > 0u ? cnt : 1u;
}
__device__ __forceinline__ void xcd_barrier(const XcdBarrier& b) {
    asm volatile("s_waitcnt vmcnt(0)" ::: "memory");
    __syncthreads();
    if (threadIdx.x == 0) {
        unsigned* bar = b.bar;
        __builtin_amdgcn_s_waitcnt(0);
        unsigned nloc = b.st[0], nx = b.st[1];
        if (nloc == 0u) { xcd_barrier_complete(bar, b.x, nloc, nx); b.st[0] = nloc; b.st[1] = nx; }
        const unsigned old = xb_add(&bar[XB_XSUB(b.x)], 1u);
        const unsigned gen = old / nloc;
        if (old + 1u == (gen + 1u) * nloc) {
            __builtin_amdgcn_fence(__ATOMIC_RELEASE, "agent");
            asm volatile("s_waitcnt vmcnt(0)" ::: "memory");
            const unsigned og = xb_add(&bar[XB_TOP], 1u);
            const unsigned tg = og / nx;
            if (og + 1u == (tg + 1u) * nx) xb_add(&bar[XB_TOPGEN], 1u);
            else XB_SPIN(xb_ld(&bar[XB_TOPGEN]) == tg, bar);
            __builtin_amdgcn_fence(__ATOMIC_ACQUIRE, "agent");
            xb_add(&bar[XB_XGEN(b.x)], 1u);
            asm volatile("s_waitcnt vmcnt(0)" ::: "memory");
        } else {
            XB_SPIN(xb_ld(&bar[XB_XGEN(b.x)]) == gen, bar);
            __builtin_amdgcn_fence(__ATOMIC_ACQUIRE, "agent");
            asm volatile("s_waitcnt vmcnt(0)" ::: "memory");
        }
    }
    __syncthreads();
}

namespace pg8 {
constexpr int BM = 256, BK = 64, HALF = 128, HTB = HALF * BK * 2, STAGE_BYTES = 8 * HTB;
__device__ __forceinline__ int lds_byte(int r, int c) { const int st = (r >> 4) * 2 + (c >> 5), rr = r & 15, cc = c & 31, ob = rr * 64 + cc * 2; return st * 1024 + (ob ^ (((ob >> 9) & 1) << 5)); }
__device__ __forceinline__ void stage_rc(int b, int& R, int& C) { const int st = b / 1024, sb = b % 1024, swz = sb ^ (((sb >> 9) & 1) << 5); R = (st >> 1) * 16 + swz / 64; C = (st & 1) * 32 + (swz % 64) / 2; }
__device__ __forceinline__ int perm32(int rho) { const int n = rho >> 4, i = rho & 15; return 8 * (i >> 2) + 4 * n + (i & 3); }

struct Unit { const char* a; const char* b; int pm, pn, kind, aux; };

template <bool GATHER, class Epi, class Sched>
__device__ __forceinline__ void gemm_phase(LAS unsigned char* lds, const int K, const unsigned lda, const unsigned ldb, const Sched& S, const Epi& E) {
    int tid_ = threadIdx.x; asm volatile("" : "+v"(tid_));
    const int tid = tid_, wid = __builtin_amdgcn_readfirstlane(tid >> 6), lane = tid & 63, wr = wid >> 2, wc = wid & 3, fr = lane & 15, fq = lane >> 4;
    const int nt = K / BK;
    int Rr[2], Cc[2]; unsigned voffB[2];
#pragma unroll
    for (int i = 0; i < 2; ++i) { stage_rc(tid * 16 + i * 8192, Rr[i], Cc[i]); const int Rb = (Rr[i] & ~31) + perm32(Rr[i] & 31); voffB[i] = (unsigned)Rb * ldb + (unsigned)Cc[i] * 2u; }
    const size_t kstep = (size_t)(BK * 2);
    const size_t hstepB = (size_t)HALF * ldb;
    const unsigned ldsw = (unsigned)wid * 1024u;
    const int aoff = lds_byte(wr * 64 + fr, fq * 8), boff = lds_byte(wc * 32 + fr, fq * 8);
#define PG8_SA(b, h) (((b) * 2 + (h)) * HTB)
#define PG8_SB(b, h) ((4 + (b) * 2 + (h)) * HTB)
#define PG8_STAGE(bufoff, gbase, voff) do { _Pragma("unroll") for (int _i = 0; _i < 2; ++_i) \
        __builtin_amdgcn_global_load_lds((const unsigned*)((const char*)(gbase) + (voff)[_i]), (LAS unsigned*)(lds + (bufoff) + ldsw + _i * 8192), 16, 0, 0); } while (0)
#define PG8_LDA(dst, b, h) do { _Pragma("unroll") for (int m = 0; m < 4; ++m) _Pragma("unroll") for (int k = 0; k < 2; ++k) dst[m][k] = *(const LAS bf16x8*)(lds + PG8_SA(b, h) + aoff + m * 2048 + k * 1024); } while (0)
#define PG8_LDB(dst, b, h) do { _Pragma("unroll") for (int n = 0; n < 2; ++n) _Pragma("unroll") for (int k = 0; k < 2; ++k) dst[n][k] = *(const LAS bf16x8*)(lds + PG8_SB(b, h) + boff + n * 2048 + k * 1024); } while (0)
#define PG8_MMA(ai, bj, At, Bt) do { __builtin_amdgcn_s_setprio(1); _Pragma("unroll") for (int m = 0; m < 4; ++m) _Pragma("unroll") for (int n = 0; n < 2; ++n) _Pragma("unroll") for (int k = 0; k < 2; ++k) \
        acc[ai][bj][m][n] = __builtin_amdgcn_mfma_f32_16x16x32_bf16(Bt[n][k], At[m][k], acc[ai][bj][m][n], 0, 0, 0); __builtin_amdgcn_s_setprio(0); } while (0)
#define PG8_WAIT_V(n) asm volatile("s_waitcnt vmcnt(" #n ")" ::: "memory")
#define PG8_WAIT_L(n) asm volatile("s_waitcnt lgkmcnt(" #n ")" ::: "memory")
#define PG8_BAR __builtin_amdgcn_s_barrier()
#define PG8_SCHED __builtin_amdgcn_sched_barrier(0)
#define PG8_OFFS(dst, ui_) do { _Pragma("unroll") for (int _h = 0; _h < 2; ++_h) _Pragma("unroll") for (int _i = 0; _i < 2; ++_i) \
        dst[_h][_i] = (GATHER ? S.rowoff((ui_), _h * HALF + Rr[_i]) : (unsigned)(_h * HALF + Rr[_i]) * lda) + (unsigned)Cc[_i] * 2u; } while (0)
    Unit cur, nxt; int ui = 0;
    if (!S.next(0, cur)) return;
    f32x4 acc[2][2][4][2];
#pragma unroll
    for (int a = 0; a < 2; ++a)
#pragma unroll
        for (int b = 0; b < 2; ++b)
#pragma unroll
            for (int m = 0; m < 4; ++m)
#pragma unroll
                for (int n = 0; n < 2; ++n) acc[a][b][m][n] = (f32x4){0.f, 0.f, 0.f, 0.f};
    bf16x8 At[4][2], B0[2][2], B1[2][2];
    unsigned oAc[2][2], oAn[2][2];
    PG8_OFFS(oAc, 0);
    const char* cA = cur.a; const char* cB = cur.b;
    PG8_STAGE(PG8_SB(0, 0), cB, voffB); PG8_STAGE(PG8_SB(0, 1), cB + hstepB, voffB); PG8_STAGE(PG8_SA(0, 0), cA, oAc[0]); PG8_STAGE(PG8_SA(0, 1), cA, oAc[1]);
    if (wr == 1) PG8_BAR;
    PG8_WAIT_V(2); PG8_BAR;
    PG8_STAGE(PG8_SB(1, 0), cB + kstep, voffB); PG8_STAGE(PG8_SA(1, 0), cA + kstep, oAc[0]); PG8_STAGE(PG8_SB(1, 1), cB + hstepB + kstep, voffB);
    PG8_WAIT_V(6); PG8_BAR;
    for (;;) {
        const bool has_next = S.next(ui + 1, nxt);
        const char* nA = has_next ? nxt.a : cA; const char* nB = has_next ? nxt.b : cB;
        if constexpr (GATHER) { if (has_next) { PG8_OFFS(oAn, ui + 1); } else {
#pragma unroll
            for (int h = 0; h < 2; ++h)
#pragma unroll
                for (int i = 0; i < 2; ++i) oAn[h][i] = oAc[h][i]; } }
        for (int t = 0; t < nt; t += 2) {
            const bool last = (t == nt - 2);
            const char* a1 = cA + (size_t)(t + 1) * kstep;
            const char* a2 = last ? nA : cA + (size_t)(t + 2) * kstep; const char* b2 = last ? nB : cB + (size_t)(t + 2) * kstep;
            const char* a3 = a2 + kstep; const char* b3 = b2 + kstep;
            unsigned oAx[2][2];
#pragma unroll
            for (int h = 0; h < 2; ++h)
#pragma unroll
                for (int i = 0; i < 2; ++i) { if constexpr (GATHER) oAx[h][i] = last ? oAn[h][i] : oAc[h][i]; else oAx[h][i] = oAc[h][i]; }
            PG8_LDB(B0, 0, 0); PG8_LDB(B1, 0, 1); PG8_SCHED; PG8_LDA(At, 0, 0); PG8_STAGE(PG8_SA(1, 1), a1, oAc[1]);
            PG8_WAIT_V(8); PG8_WAIT_L(0); PG8_BAR; PG8_MMA(0, 0, At, B0); PG8_MMA(0, 1, At, B1); PG8_BAR; PG8_SCHED;
            PG8_LDA(At, 0, 1); PG8_STAGE(PG8_SB(0, 0), b2, voffB); PG8_STAGE(PG8_SB(0, 1), b2 + hstepB, voffB); PG8_STAGE(PG8_SA(0, 0), a2, oAx[0]);
            PG8_WAIT_V(8); PG8_WAIT_L(0); PG8_BAR; PG8_MMA(1, 0, At, B0); PG8_MMA(1, 1, At, B1); PG8_BAR; PG8_SCHED;
            PG8_LDB(B0, 1, 0); PG8_LDB(B1, 1, 1); PG8_SCHED; PG8_LDA(At, 1, 0); PG8_STAGE(PG8_SA(0, 1), a2, oAx[1]);
            PG8_WAIT_V(8); PG8_WAIT_L(0); PG8_BAR; PG8_MMA(0, 0, At, B0); PG8_MMA(0, 1, At, B1); PG8_BAR; PG8_SCHED;
            PG8_LDA(At, 1, 1); PG8_STAGE(PG8_SB(1, 0), b3, voffB); PG8_STAGE(PG8_SB(1, 1), b3 + hstepB, voffB); PG8_STAGE(PG8_SA(1, 0), a3, oAx[0]);
            PG8_WAIT_V(8); PG8_WAIT_L(0); PG8_BAR; PG8_MMA(1, 0, At, B0); PG8_MMA(1, 1, At, B1); PG8_BAR; PG8_SCHED;
        }
        if (wr == 0) PG8_BAR;
        E(acc, cur, wr, wc, fr, fq);
        if (!has_next) break;
#pragma unroll
        for (int a = 0; a < 2; ++a)
#pragma unroll
            for (int b = 0; b < 2; ++b)
#pragma unroll
                for (int m = 0; m < 4; ++m)
#pragma unroll
                    for (int n = 0; n < 2; ++n) acc[a][b][m][n] = (f32x4){0.f, 0.f, 0.f, 0.f};
        cur = nxt; cA = nA; cB = nB; ++ui;
        if constexpr (GATHER) {
#pragma unroll
        for (int h = 0; h < 2; ++h)
#pragma unroll
            for (int i = 0; i < 2; ++i) oAc[h][i] = oAn[h][i]; }
        if (wr == 1) PG8_BAR;
    }
    PG8_WAIT_V(0);
    PG8_BAR;
#undef PG8_SA
#undef PG8_SB
#undef PG8_STAGE
#undef PG8_LDA
#undef PG8_LDB
#undef PG8_MMA
#undef PG8_WAIT_V
#undef PG8_WAIT_L
#undef PG8_BAR
#undef PG8_SCHED
#undef PG8_OFFS
}
}
constexpr size_t al256(size_t x) { return (x + 255) & ~(size_t)255; }
constexpr size_t WS_CTL = 0, CTL_ZERO_BYTES = 1u << 20;
constexpr int CW_BAR = 4096;
constexpr size_t CTL_MOD = 65536;
constexpr int NIN_MAIN = 3328, NIN_F = 1024, NUP = 1792, KUP = 768;
constexpr size_t WS_WIN  = CTL_ZERO_BYTES;
constexpr size_t WS_WUP  = WS_WIN  + al256((size_t)2 * (NIN_MAIN + NIN_F) * D * 2);
constexpr size_t WS_WO   = WS_WUP  + al256((size_t)2 * NUP * KUP * 2);
constexpr size_t WS_WGU  = WS_WO   + al256((size_t)2 * D * D * 2);
constexpr size_t WS_WD   = WS_WGU  + al256((size_t)2 * NE * 2 * FF * D * 2);
constexpr size_t WS_DN   = WS_WD   + al256((size_t)2 * NE * D * FF * 2);
constexpr size_t WS_DL   = WS_DN   + al256((size_t)SEQ * 2 * SEQ * 2);
constexpr size_t WS_ROPS = WS_DL   + al256((size_t)CTXL * 2 * CTXL * 2);
constexpr size_t WS_ROPM = WS_ROPS + al256((size_t)SEQ * 32 * 8);
constexpr size_t WS_X    = WS_ROPM + al256((size_t)SEQ * 16 * 8);
constexpr size_t WS_H    = WS_X    + al256((size_t)T * D * 4);
constexpr size_t WS_PC   = WS_H    + al256((size_t)T * D * 2);
constexpr size_t WS_SQ   = WS_PC   + al256((size_t)T * 1536 * 2);
constexpr size_t WS_KS   = WS_SQ   + al256((size_t)T * 512 * 2);
constexpr size_t WS_VS   = WS_KS   + al256((size_t)NB * KVR * 128 * 2);
constexpr size_t WS_MCQ  = WS_VS   + al256((size_t)NB * KVR * 128 * 2);
constexpr size_t WS_QM   = WS_MCQ  + al256((size_t)T * 768 * 2);
constexpr size_t WS_KM   = WS_QM   + al256((size_t)T * 768 * 2);
constexpr size_t WS_VM   = WS_KM   + al256((size_t)NB * KVR * 768 * 2);
constexpr size_t WS_KPE  = WS_KM + (size_t)NB * KVR * 512 * 2;
constexpr size_t WS_GT   = WS_VM   + al256((size_t)NB * KVR * 512 * 2);
constexpr size_t WS_GTC  = WS_GT   + al256((size_t)NB * 512 * 8192 * 2);
constexpr size_t WS_YMIX = WS_GTC  + al256((size_t)NB * 512 * 512 * 2);
constexpr size_t WS_SSQ  = WS_YMIX + al256((size_t)T * D * 2);
constexpr size_t WS_MODP = WS_SSQ  + al256((size_t)T * 12 * 4);
constexpr int ADA_KC = 8;
constexpr size_t WS_AFF  = WS_MODP + al256((size_t)ADA_KC * 2 * 5 * 6 * D * 4);
constexpr size_t WS_POS  = WS_AFF  + al256((size_t)T * 16 * 4);
constexpr size_t WS_TOK  = WS_POS  + al256((size_t)T * 16 * 4);
constexpr size_t WS_ACT  = WS_TOK  + al256((size_t)NE * EROWS * 4);
constexpr size_t WS_Y    = WS_ACT  + al256((size_t)NE * EROWS * FF * 2);
constexpr size_t WS_GTF  = WS_Y    + al256((size_t)NE * EROWS * D * 2);
constexpr size_t WS_END  = WS_GTF  + al256((size_t)NB * 512 * SEQ * 2);

constexpr int RING_BYTES = 131072;
constexpr int LDS_TOK = RING_BYTES;
constexpr int LDS_MISC = LDS_TOK + 16 * 1024;
constexpr int LDS_ARGS = LDS_MISC + 256;
constexpr int LDS_BYTES = LDS_ARGS + 256;
__device__ __forceinline__ const float* lds_arg(LAS unsigned char* lds, int i) { const u32x2 v = *(const LAS u32x2*)(lds + LDS_ARGS + 8 * i); const unsigned lo = __builtin_amdgcn_readfirstlane(v.x), hi = __builtin_amdgcn_readfirstlane(v.y); return (const float*)(const GAS float*)(((unsigned long long)hi << 32) | lo); }
#define IN(i) lds_arg(lds, (i))

#define EPI_ARGS const f32x4 (&acc)[2][2][4][2], const pg8::Unit& u, int wr, int wc, int fr, int fq
#define EPI_OPAQUE() asm volatile("" : "+v"(fr), "+v"(fq))
__device__ __forceinline__ u32x4 pack8(const f32x4 a, const f32x4 b) { u32x4 w; w.x = cvtpk(a[0], a[1]); w.y = cvtpk(a[2], a[3]); w.z = cvtpk(b[0], b[1]); w.w = cvtpk(b[2], b[3]); return w; }
__device__ __forceinline__ u32x2 pack4(const f32x4 a) { u32x2 w; w.x = cvtpk(a[0], a[1]); w.y = cvtpk(a[2], a[3]); return w; }
__device__ __forceinline__ void rope4(f32x4& x1, f32x4& x2, const f32x2* cs) {
#pragma unroll
    for (int j = 0; j < 4; ++j) { const f32x2 c = cs[j]; const float a = x1[j], b = x2[j]; x1[j] = a * c.x - b * c.y; x2[j] = b * c.x + a * c.y; }
}

struct EpiInproj {
    unsigned char* ws;
    __device__ __forceinline__ void operator()(EPI_ARGS) const { EPI_OPAQUE();
        bf16* const PC = (bf16*)(ws + WS_PC); bf16* const SQ = (bf16*)(ws + WS_SQ); bf16* const KS = (bf16*)(ws + WS_KS); bf16* const VS = (bf16*)(ws + WS_VS); bf16* const MCQ = (bf16*)(ws + WS_MCQ);
        bf16* const KM = (bf16*)(ws + WS_KM); bf16* const GT = (bf16*)(ws + WS_GT); bf16* const GTC = (bf16*)(ws + WS_GTC); float* const SSQ = (float*)(ws + WS_SSQ);
        const f32x2* const ROPS = (const f32x2*)(ws + WS_ROPS); const f32x2* const ROPM = (const f32x2*)(ws + WS_ROPM);
        if (u.kind == 1) {
#pragma unroll
            for (int ai = 0; ai < 2; ++ai)
#pragma unroll
                for (int m = 0; m < 4; ++m) {
                    const int r = 256 * u.pm + 128 * ai + 64 * wr + 16 * m + fr, g = r >> 6, s = r & 63; const bool is_sin = s > 32; const int cq = is_sin ? s - 32 : s, part = is_sin ? 1 : 0;
                    const bool mir = (cq & 31) != 0; const int j0 = g * 64 + cq, j1 = g * 64 + ((64 - cq) & 63); const unsigned flip = is_sin ? 0x80008000u : 0u;
#pragma unroll
                    for (int bj = 0; bj < 2; ++bj) { const int tok = 256 * u.pn + 128 * bj + 32 * wc + 8 * fq; bf16* d0; size_t rs, ps;
                        if (tok < TL) { d0 = GT + (size_t)(tok >> 12) * 512 * 8192 + (tok & 4095); rs = 8192; ps = 4096; }
                        else { const int tc = tok - TL; d0 = GTC + (size_t)(tc >> 8) * 512 * 512 + (tc & 255); rs = 512; ps = 256; }
                        const u32x4 v = pack8(acc[ai][bj][m][0], acc[ai][bj][m][1]);
                        *(u32x4*)(d0 + j0 * rs + part * ps) = v;
                        if (mir) *(u32x4*)(d0 + j1 * rs + part * ps) = (u32x4){v.x ^ flip, v.y ^ flip, v.z ^ flip, v.w ^ flip};
                        else *(u32x4*)(d0 + j0 * rs + ps) = (u32x4){0u, 0u, 0u, 0u}; } }
            return;
        }
        const int pn = u.pn;
#pragma unroll
        for (int ai = 0; ai < 2; ++ai)
#pragma unroll
            for (int m = 0; m < 4; ++m) {
                int t = 256 * u.pm + 128 * ai + 64 * wr + 16 * m + fr; asm volatile("" : "+v"(t)); const bool lat = t < TL; const int npos = t & (SEQ - 1);
                if (pn < 6) {
#pragma unroll
                    for (int bj = 0; bj < 2; ++bj) *(u32x4*)(PC + (size_t)t * 1536 + 256 * pn + 128 * bj + 32 * wc + 8 * fq) = pack8(acc[ai][bj][m][0], acc[ai][bj][m][1]);
                } else if (pn < 8) {
#pragma unroll
                    for (int bj = 0; bj < 2; ++bj) { const int hc = 256 * (pn - 6) + 128 * bj + 32 * wc + 8 * fq, head = hc >> 6, a = (hc & 63) >> 3;
                        f32x4 x1 = acc[ai][bj][m][0], x2 = acc[ai][bj][m][1];
                        if (lat) rope4(x1, x2, ROPS + npos * 32 + 4 * a);
                        x1 *= QSC_S; x2 *= QSC_S;
                        bf16* o = SQ + (size_t)t * 512 + head * 64 + 4 * a; *(u32x2*)o = pack4(x1); *(u32x2*)(o + 32) = pack4(x2); }
                } else if (pn == 8) {
                    const int kr = kv_row(t);
                    { const int hc = 32 * wc + 8 * fq, head = hc >> 6, a = (hc & 63) >> 3; f32x4 x1 = acc[ai][0][m][0], x2 = acc[ai][0][m][1];
                      if (lat) rope4(x1, x2, ROPS + npos * 32 + 4 * a);
                      bf16* o = KS + (size_t)kr * 128 + head * 64 + 4 * a; *(u32x2*)o = pack4(x1); *(u32x2*)(o + 32) = pack4(x2); }
                    *(u32x4*)(VS + (size_t)kr * 128 + 32 * wc + 8 * fq) = pack8(acc[ai][1][m][0], acc[ai][1][m][1]);
                } else if (pn < 12) {
                    const int cb = pn < 11 ? 256 * (pn - 9) : 512; float s = 0.f;
#pragma unroll
                    for (int bj = 0; bj < 2; ++bj) { const f32x4 v0 = acc[ai][bj][m][0], v1 = acc[ai][bj][m][1];
                        *(u32x4*)(MCQ + (size_t)t * 768 + cb + 128 * bj + 32 * wc + 8 * fq) = pack8(v0, v1);
                        s += (v0[0] * v0[0] + v0[1] * v0[1]) + (v0[2] * v0[2] + v0[3] * v0[3]) + (v1[0] * v1[0] + v1[1] * v1[1]) + (v1[2] * v1[2] + v1[3] * v1[3]); }
                    s += __shfl_xor(s, 16); s += __shfl_xor(s, 32);
                    if (fq == 0) SSQ[(size_t)t * 12 + (pn - 9) * 4 + wc] = s;
                } else {
                    if (wc == 0) { const int a = fq; f32x4 x1 = acc[ai][0][m][0], x2 = acc[ai][0][m][1];
                        if (lat) rope4(x1, x2, ROPM + npos * 16 + 4 * a);
                        bf16* o = (bf16*)(ws + WS_KPE) + (size_t)kv_row(t) * 32 + 4 * a; *(u32x2*)o = pack4(x1); *(u32x2*)(o + 16) = pack4(x2); }
                }
                asm volatile("" ::: "memory");
            }
    }
};

struct EpiUp {
    unsigned char* ws;
    __device__ __forceinline__ void operator()(EPI_ARGS) const { EPI_OPAQUE();
        bf16* const QM = (bf16*)(ws + WS_QM); bf16* const KM = (bf16*)(ws + WS_KM); bf16* const VM = (bf16*)(ws + WS_VM); const float* const SSQ = (const float*)(ws + WS_SSQ); const f32x2* const ROPM = (const f32x2*)(ws + WS_ROPM);
        const int pn = u.pn; const bool isq = (u.aux == 0);
#pragma unroll
        for (int ai = 0; ai < 2; ++ai)
#pragma unroll
            for (int m = 0; m < 4; ++m) {
                int t = 256 * u.pm + 128 * ai + 64 * wr + 16 * m + fr; asm volatile("" : "+v"(t)); const bool lat = t < TL; const int npos = t & (SEQ - 1);
                if (isq) {
                    const f32x4 sa = *(const f32x4*)(SSQ + (size_t)t * 12), sb = *(const f32x4*)(SSQ + (size_t)t * 12 + 4);
                    const float rs = rsqrtf((((sa[0] + sa[1]) + (sa[2] + sa[3])) + ((sb[0] + sb[1]) + (sb[2] + sb[3]))) * (1.0f / 512.0f) + EPS) * QSC_M;
#pragma unroll
                    for (int bj = 0; bj < 2; ++bj) { const int c0 = 256 * pn + 128 * bj + 32 * wc + 8 * fq, head = c0 / 96, w = c0 - head * 96;
                        f32x4 x1 = acc[ai][bj][m][0], x2 = acc[ai][bj][m][1];
                        if (w < 64) { x1 *= rs; x2 *= rs; *(u32x4*)(QM + (size_t)t * 768 + c0) = pack8(x1, x2); }
                        else { const int a = (w - 64) >> 3; if (lat) rope4(x1, x2, ROPM + npos * 16 + 4 * a); x1 *= rs; x2 *= rs;
                            bf16* o = QM + (size_t)t * 768 + head * 96 + 64 + 4 * a; *(u32x2*)o = pack4(x1); *(u32x2*)(o + 16) = pack4(x2); } }
                } else {
                    const f32x4 sc = *(const f32x4*)(SSQ + (size_t)t * 12 + 8);
                    const float rs = rsqrtf(((sc[0] + sc[1]) + (sc[2] + sc[3])) * (1.0f / 256.0f) + EPS); const int kr = kv_row(t);
#pragma unroll
                    for (int bj = 0; bj < 2; ++bj) { const int c0 = 256 * pn + 128 * bj + 32 * wc + 8 * fq, head = c0 >> 7, w = c0 & 127;
                        const f32x4 x1 = acc[ai][bj][m][0] * rs, x2 = acc[ai][bj][m][1] * rs;
                        if (w < 64) *(u32x4*)(KM + (size_t)kr * 512 + head * 64 + w) = pack8(x1, x2);
                        else *(u32x4*)(VM + (size_t)kr * 512 + head * 64 + (w - 64)) = pack8(x1, x2); } }
                asm volatile("" ::: "memory");
            }
    }
};

struct EpiFnet {
    bf16* YMIX;
    __device__ __forceinline__ void operator()(EPI_ARGS) const { EPI_OPAQUE();
#pragma unroll
        for (int ai = 0; ai < 2; ++ai)
#pragma unroll
            for (int m = 0; m < 4; ++m) { const int t = u.aux * SEQ + 256 * u.pm + 128 * ai + 64 * wr + 16 * m + fr;
#pragma unroll
                for (int bj = 0; bj < 2; ++bj) *(u32x4*)(YMIX + (size_t)t * D + 1024 + 256 * u.pn + 128 * bj + 32 * wc + 8 * fq) = pack8(acc[ai][bj][m][0], acc[ai][bj][m][1]); }
    }
};

struct EpiOut {
    const float *xl, *xc; const bf16* xb; bf16* X; const float* MODL;
    __device__ __forceinline__ void operator()(EPI_ARGS) const { EPI_OPAQUE();
        const int tb = 256 * u.pm, cb = 256 * u.pn + 32 * wc + 8 * fq; const float* g1 = MODL + mod_row(tb) * 6 * D + 2 * D + cb;
        f32x4 gv[2][2];
#pragma unroll
        for (int bj = 0; bj < 2; ++bj)
#pragma unroll
            for (int n = 0; n < 2; ++n) gv[bj][n] = *(const f32x4*)(g1 + 128 * bj + 4 * n);
        if (xb) {
#pragma unroll
            for (int ai = 0; ai < 2; ++ai)
#pragma unroll
                for (int m2 = 0; m2 < 4; m2 += 2) { u32x4 w[2][2];
#pragma unroll
                    for (int mm = 0; mm < 2; ++mm) { const bf16* xin = xb + (size_t)(tb + 128 * ai + 64 * wr + 16 * (m2 + mm) + fr) * D + cb; w[mm][0] = *(const u32x4*)xin; w[mm][1] = *(const u32x4*)(xin + 128); }
#pragma unroll
                    for (int mm = 0; mm < 2; ++mm) { bf16* xo = X + (size_t)(tb + 128 * ai + 64 * wr + 16 * (m2 + mm) + fr) * D + cb;
#pragma unroll
                        for (int bj = 0; bj < 2; ++bj) { const u32x4 q = w[mm][bj]; const f32x4 x0 = {bf_lo(q.x), bf_hi(q.x), bf_lo(q.y), bf_hi(q.y)}, x1 = {bf_lo(q.z), bf_hi(q.z), bf_lo(q.w), bf_hi(q.w)};
                            *(u32x4*)(xo + 128 * bj) = pack8(x0 + gv[bj][0] * acc[ai][bj][m2 + mm][0], x1 + gv[bj][1] * acc[ai][bj][m2 + mm][1]); } }
                    asm volatile("" ::: "memory"); }
        } else {
#pragma unroll
            for (int ai = 0; ai < 2; ++ai)
#pragma unroll
                for (int m = 0; m < 4; ++m) { const int t = tb + 128 * ai + 64 * wr + 16 * m + fr; const float* xin = (t < TL ? xl + (size_t)t * D : xc + (size_t)(t - TL) * D) + cb; bf16* xo = X + (size_t)t * D + cb;
                    f32x4 xi[2][2];
#pragma unroll
                    for (int bj = 0; bj < 2; ++bj)
#pragma unroll
                        for (int n = 0; n < 2; ++n) xi[bj][n] = *(const f32x4*)(xin + 128 * bj + 4 * n);
#pragma unroll
                    for (int bj = 0; bj < 2; ++bj) *(u32x4*)(xo + 128 * bj) = pack8(xi[bj][0] + gv[bj][0] * acc[ai][bj][m][0], xi[bj][1] + gv[bj][1] * acc[ai][bj][m][1]);
                    asm volatile("" ::: "memory"); }
        }
    }
};

struct EpiGU {
    bf16* ACT;
    __device__ __forceinline__ void operator()(EPI_ARGS) const { EPI_OPAQUE();
#pragma unroll
        for (int ai = 0; ai < 2; ++ai)
#pragma unroll
            for (int m = 0; m < 4; ++m) { const int row = u.aux * EROWS + 256 * u.pm + 128 * ai + 64 * wr + 16 * m + fr; f32x4 o[2];
#pragma unroll
                for (int n = 0; n < 2; ++n) { const f32x4 g = acc[ai][0][m][n], up = acc[ai][1][m][n];
#pragma unroll
                    for (int j = 0; j < 4; ++j) o[n][j] = g[j] * __builtin_amdgcn_rcpf(1.0f + __builtin_amdgcn_exp2f(-g[j] * LOG2E)) * up[j]; }
                *(u32x4*)(ACT + (size_t)row * FF + 128 * u.pn + 32 * wc + 8 * fq) = pack8(o[0], o[1]); }
    }
};

struct EpiDown {
    bf16* Y;
    __device__ __forceinline__ void operator()(EPI_ARGS) const { EPI_OPAQUE();
#pragma unroll
        for (int ai = 0; ai < 2; ++ai)
#pragma unroll
            for (int m = 0; m < 4; ++m) { const int row = u.aux * EROWS + 256 * u.pm + 128 * ai + 64 * wr + 16 * m + fr;
#pragma unroll
                for (int bj = 0; bj < 2; ++bj) *(u32x4*)(Y + (size_t)row * D + 256 * u.pn + 128 * bj + 32 * wc + 8 * fq) = pack8(acc[ai][bj][m][0], acc[ai][bj][m][1]); }
    }
};

__device__ __forceinline__ void static_tile(int L, int nM, int nN, int& pm, int& pn) {
    const int nwg = nM * nN; int wgid = L; { const int q = nwg / 8, r = nwg % 8, xcd = wgid % 8, off = wgid / 8; wgid = (xcd < r ? xcd * (q + 1) : r * (q + 1) + (xcd - r) * q) + off; }
    const int nig = 8 * nN, gid = wgid / nig, fm = gid * 8, gsz = (nM - fm) < 8 ? (nM - fm) : 8;
    pm = fm + ((wgid % nig) % gsz); pn = (wgid % nig) / gsz;
}
struct SchedInproj {
    const char *H, *WM, *WF; int G, c;
    __device__ __forceinline__ bool next(int i, pg8::Unit& u) const {
        const int L = i * G + c; constexpr int NMAIN = 68 * 13;
        if (L < NMAIN) { static_tile(L, 68, 13, u.pm, u.pn); u.kind = 0; u.aux = 0; u.a = H + (size_t)u.pm * 256 * D * 2; u.b = WM + (size_t)u.pn * 256 * D * 2; return true; }
        const int k = L - NMAIN; if (k >= 2 * 68) return false;
        u.pm = k & 1; u.pn = k >> 1; u.kind = 1; u.aux = 0; u.a = WF + (size_t)u.pm * 256 * D * 2; u.b = H + (size_t)u.pn * 256 * D * 2; return true;
    }
    __device__ __forceinline__ unsigned rowoff(int, int) const { return 0u; }
};
struct SchedPlain {
    const char *A, *B; int nM, nN, G, c; unsigned lda, ldb; int aux;
    __device__ __forceinline__ bool next(int i, pg8::Unit& u) const {
        const int L = i * G + c; if (L >= nM * nN) return false;
        static_tile(L, nM, nN, u.pm, u.pn); u.kind = 0; u.aux = aux; u.a = A + (size_t)u.pm * 256 * lda; u.b = B + (size_t)u.pn * 256 * ldb; return true;
    }
    __device__ __forceinline__ unsigned rowoff(int, int) const { return 0u; }
};
struct SchedFnet {
    const char *DN, *GT; int c, G;
    __device__ __forceinline__ bool next(int i, pg8::Unit& u) const {
        int pm, bp;
        if (G == 256) { const int x = c & 7, li = c >> 3; if (i > 0 || li >= 16) return false; pm = (x & 3) * 4 + (li & 3); bp = (x >> 2) * 4 + (li >> 2); }
        else { const int id = c + i * G; if (id >= 128) return false; pm = id & 15; bp = id >> 4; }
        const int b = bp >> 1, pn = bp & 1;
        u.pm = pm; u.pn = pn; u.kind = 0; u.aux = b; u.a = DN + (size_t)pm * 256 * SEQ * 2; u.b = GT + (size_t)(b * 512 + pn * 256) * SEQ * 2; return true;
    }
    __device__ __forceinline__ unsigned rowoff(int, int) const { return 0u; }
};
struct SchedFnetC {
    const char *DL, *GTC; int c, G;
    __device__ __forceinline__ bool next(int i, pg8::Unit& u) const {
        int id; if (G == 256) { if (i > 0 || (c >> 3) != 8) return false; id = c & 7; } else { id = c + i * G; if (id >= 8) return false; }
        u.pm = 0; u.pn = id & 1; u.aux = id >> 1; u.kind = 0; u.a = DL; u.b = GTC + (size_t)(u.aux * 512 + u.pn * 256) * 512 * 2; return true;
    }
    __device__ __forceinline__ unsigned rowoff(int, int) const { return 0u; }
};
struct EpiFnetC {
    bf16* YMIX;
    __device__ __forceinline__ void operator()(EPI_ARGS) const { EPI_OPAQUE();
#pragma unroll
        for (int ai = 0; ai < 2; ++ai)
#pragma unroll
            for (int m = 0; m < 4; ++m) { const int t = TL + u.aux * CTXL + 128 * ai + 64 * wr + 16 * m + fr;
#pragma unroll
                for (int bj = 0; bj < 2; ++bj) *(u32x4*)(YMIX + (size_t)t * D + 1024 + 256 * u.pn + 128 * bj + 32 * wc + 8 * fq) = pack8(acc[ai][bj][m][0], acc[ai][bj][m][1]); }
    }
};
struct SchedMoe {
    const char *A, *B; int npm, nN, G, c; size_t sA, sB; unsigned ldb; const LAS int* tokl;
    __device__ __forceinline__ bool next(int i, pg8::Unit& u) const {
        const int per = npm * nN, nwg = NE * per; const int L = i * G + c; if (L >= nwg) return false;
        const int wgid = (L & 7) * (nwg >> 3) + (L >> 3);
        const int e = wgid / per, rem = wgid - e * per; u.pn = rem / npm; u.pm = rem - u.pn * npm; u.aux = e; u.kind = 0;
        u.a = A + (size_t)e * sA + (size_t)u.pm * 256 * (size_t)(D * 2) * (sA ? 1 : 0); u.b = B + (size_t)e * sB + (size_t)u.pn * 256 * ldb; return true;
    }
    __device__ __forceinline__ unsigned rowoff(int i, int r) const { return (unsigned)tokl[i * 256 + r] * (unsigned)(D * 2); }
};
namespace att {
constexpr int NSLOT = 4, LK = 0, KSLOT = 12288, LV = NSLOT * KSLOT, VSLOT = 8192, LWS = LV + NSLOT * VSLOT, LOST = LWS + NWAVES * 256, LDS_NEED = LOST + NWAVES * 4096;
static_assert(LDS_NEED <= RING_BYTES, "attention LDS");
typedef LAS const char* lds_cptr;
#define ATT_SBAR() __builtin_amdgcn_sched_barrier(0)
__device__ __forceinline__ int crow(int r, int hi) { return (r & 3) + 8 * (r >> 2) + 4 * hi; }
__device__ __forceinline__ void glds16(const void* gsrc, unsigned lds_dst) { unsigned keep;
    asm volatile("s_mov_b32 %0, m0\n\ts_mov_b32 m0, %2\n\ts_nop 0\n\tglobal_load_lds_dwordx4 %1, off\n\ts_mov_b32 m0, %0" : "=&s"(keep) : "v"(gsrc), "s"(lds_dst) : "memory"); }
__device__ __forceinline__ float vmax3(float a, float b, float c) { float d; asm("v_max3_f32 %0, %1, %2, %3" : "=v"(d) : "v"(a), "v"(b), "v"(c)); return d; }
__device__ __forceinline__ float rowmax(const f32x16& p0, const f32x16& p1) {
    float a = fmaxf(p0[0], p1[0]);
#pragma unroll
    for (int r = 1; r < 16; ++r) a = fmaxf(a, fmaxf(p0[r], p1[r]));
    auto rr = __builtin_amdgcn_permlane32_swap(__float_as_uint(a), __float_as_uint(a), false, false);
    return fmaxf(__uint_as_float(rr[0]), __uint_as_float(rr[1]));
}
__device__ __forceinline__ void pv(f32x16* o, int vb, bf16x8 pa0, bf16x8 pa1, bf16x8 pa2, bf16x8 pa3) {
    s16x4 lo[2][4], hi[2][4];
#pragma unroll
    for (int d0 = 0; d0 < 2; ++d0)
#pragma unroll
        for (int ks = 0; ks < 4; ++ks) {
            asm volatile("ds_read_b64_tr_b16 %0,%1 offset:%c2" : "=&v"(lo[d0][ks]) : "v"(vb), "i"(d0 * 4096 + ks * 1024) : "memory");
            asm volatile("ds_read_b64_tr_b16 %0,%1 offset:%c2" : "=&v"(hi[d0][ks]) : "v"(vb), "i"(d0 * 4096 + ks * 1024 + 512) : "memory"); }
    asm volatile("s_waitcnt lgkmcnt(0)" ::: "memory"); ATT_SBAR();
#define ATT_PK(d, k) (bf16x8){lo[d][k][0], lo[d][k][1], lo[d][k][2], lo[d][k][3], hi[d][k][0], hi[d][k][1], hi[d][k][2], hi[d][k][3]}
    o[0] = __builtin_amdgcn_mfma_f32_32x32x16_bf16(pa0, ATT_PK(0, 0), o[0], 0, 0, 0); o[1] = __builtin_amdgcn_mfma_f32_32x32x16_bf16(pa0, ATT_PK(1, 0), o[1], 0, 0, 0);
    o[0] = __builtin_amdgcn_mfma_f32_32x32x16_bf16(pa1, ATT_PK(0, 1), o[0], 0, 0, 0); o[1] = __builtin_amdgcn_mfma_f32_32x32x16_bf16(pa1, ATT_PK(1, 1), o[1], 0, 0, 0);
    o[0] = __builtin_amdgcn_mfma_f32_32x32x16_bf16(pa2, ATT_PK(0, 2), o[0], 0, 0, 0); o[1] = __builtin_amdgcn_mfma_f32_32x32x16_bf16(pa2, ATT_PK(1, 2), o[1], 0, 0, 0);
    o[0] = __builtin_amdgcn_mfma_f32_32x32x16_bf16(pa3, ATT_PK(0, 3), o[0], 0, 0, 0); o[1] = __builtin_amdgcn_mfma_f32_32x32x16_bf16(pa3, ATT_PK(1, 3), o[1], 0, 0, 0);
#undef ATT_PK
}
template <int DQ, bool SWA>
__device__ __forceinline__ void attn_unit(LAS unsigned char* lds, const bf16* Qw, const int qld, const bf16* Kh, const int kld, const bf16* Kpe, const bf16* Vh, const int vld, bf16* Ow,
                                          const int a0, const int n1, const int n2, const int qpos0, const float mhat0, const float l0) {
    constexpr int NKS = DQ / 16; constexpr float THR = 6.0f;
    int tid_ = threadIdx.x; asm volatile("" : "+v"(tid_));
    const int tid = tid_, lane = tid & 63, r32 = lane & 31, hi = lane >> 5; const int wid = __builtin_amdgcn_readfirstlane(tid >> 6);
    const unsigned lds0 = (unsigned)(uintptr_t)lds;
    LAS float* wsf = (LAS float*)(lds + LWS) + wid * 64;
    const bf16* ksrc0 = Kh + (size_t)lane * kld + wid * 8;
    const bf16* ksrc1 = Kpe + (size_t)lane * 32 + (wid & 3) * 8;
    const bf16* vsrc = Vh + (size_t)(16 * (wid & 3) + (lane >> 2)) * vld + (wid >> 2) * 32 + (lane & 3) * 8;
    const unsigned kdst0 = lds0 + LK + wid * 1024, kdst1 = lds0 + LK + (8 + (wid & 3)) * 1024, vdst = lds0 + LV + wid * 1024;
    const int NT = n1 + n2;
#define ATT_TILE(i) ((i) < n1 ? a0 + (i) : 64 + (i) - n1)
#define ATT_DMA(i) do { const size_t ko_ = (size_t)ATT_TILE(i) * 64; const int s_ = (i) & 3; glds16(ksrc0 + ko_ * kld, (unsigned)__builtin_amdgcn_readfirstlane(kdst0 + s_ * KSLOT)); \
        if (DQ == 96) glds16(ksrc1 + ko_ * 32, (unsigned)__builtin_amdgcn_readfirstlane(kdst1 + s_ * KSLOT)); \
        glds16(vsrc + ko_ * vld, (unsigned)__builtin_amdgcn_readfirstlane(vdst + s_ * VSLOT)); } while (0)
#define ATT_WAIT_BAR(N) asm volatile("s_waitcnt vmcnt(" #N ") lgkmcnt(0)\n\ts_barrier" ::: "memory")
#define ATT_QK(P0, P1, i) do { const lds_cptr kp_ = kp0 + ((i) & 3) * KSLOT; P0 = f32x16{}; P1 = f32x16{}; \
        _Pragma("unroll") for (int d0 = 0; d0 < NKS; ++d0) { const bf16x8 b0_ = *(const LAS bf16x8*)(kp_ + d0 * 2048), b1_ = *(const LAS bf16x8*)(kp_ + d0 * 2048 + 512); \
            P0 = __builtin_amdgcn_mfma_f32_32x32x16_bf16(b0_, qr[d0], P0, 0, 0, 0); P1 = __builtin_amdgcn_mfma_f32_32x32x16_bf16(b1_, qr[d0], P1, 0, 0, 0); } } while (0)
    bf16x8 qr[NKS];
#pragma unroll
    for (int d0 = 0; d0 < NKS; ++d0) qr[d0] = *(const bf16x8*)(Qw + (size_t)r32 * qld + d0 * 16 + hi * 8);
    if (wid >= 4) __builtin_amdgcn_s_setprio(1);
    ATT_DMA(0); ATT_DMA(1); ATT_DMA(2);
    float mhat = mhat0, l_reg = (hi == 0) ? l0 : 0.f; f32x16 o[2]; o[0] = f32x16{}; o[1] = f32x16{};
    const int vb0 = (int)(lds0 + LV) + ((lane >> 4) & 1) * 32 + (lane & 3) * 8 + (4 * hi + ((lane & 15) >> 2)) * 64;
    const lds_cptr kp0 = (lds_cptr)(lds + LK) + hi * 1024 + r32 * 16;
    const int qpos = qpos0 + wid * 32 + r32;
#define ATT_MASK(P0, P1, i) do { if (SWA) { const int kb_ = ((i) < n1) ? 64 * (a0 + (i)) + 4 * hi - qpos : 0; \
        _Pragma("unroll") for (int r = 0; r < 16; ++r) { const int rel_ = kb_ + (r & 3) + 8 * (r >> 2); P0[r] = (rel_ > 128 || rel_ < -128) ? -1e30f : P0[r]; P1[r] = (rel_ + 32 > 128 || rel_ + 32 < -128) ? -1e30f : P1[r]; } } } while (0)
#define ATT_RESCALE(rm_) do { if (__any((rm_) > mhat + THR)) { const float mn_ = fmaxf(mhat, (rm_)), f_ = __builtin_amdgcn_exp2f(mhat - mn_); l_reg *= f_; mhat = mn_; \
        if (hi == 0) wsf[r32] = f_; asm volatile("s_waitcnt lgkmcnt(0)" ::: "memory"); \
        _Pragma("unroll") for (int d = 0; d < 2; ++d) _Pragma("unroll") for (int r = 0; r < 16; ++r) o[d][r] *= wsf[crow(r, hi)]; \
        asm volatile("s_waitcnt lgkmcnt(0)" ::: "memory"); } } while (0)
#define ATT_RESCALE_N(rp_, N0_, N1_) do { if (__any((rp_) > THR)) { const float d_ = fmaxf((rp_), 0.f), f_ = __builtin_amdgcn_exp2f(-d_); l_reg *= f_; \
        if (hi == 0) wsf[r32] = f_; asm volatile("s_waitcnt lgkmcnt(0)" ::: "memory"); \
        _Pragma("unroll") for (int d = 0; d < 2; ++d) _Pragma("unroll") for (int r = 0; r < 16; ++r) o[d][r] *= wsf[crow(r, hi)]; \
        _Pragma("unroll") for (int r = 0; r < 16; ++r) { N0_[r] -= d_; N1_[r] -= d_; negm[r] -= d_; } \
        asm volatile("s_waitcnt lgkmcnt(0)" ::: "memory"); } } while (0)
    f32x16 p0, p1, n0, n1v, negm;
    if (DQ == 96) ATT_WAIT_BAR(6); else ATT_WAIT_BAR(4);
    ATT_QK(p0, p1, 0); ATT_MASK(p0, p1, 0);
    { const float rm0 = rowmax(p0, p1); ATT_RESCALE(rm0); }
#pragma unroll
    for (int r = 0; r < 16; ++r) { p0[r] -= mhat; p1[r] -= mhat; negm[r] = -mhat; }
    constexpr int CB6[7] = {0, 4, 8, 12, 16, 20, 24}, CB4[5] = {0, 6, 12, 18, 24};
    auto step = [&](f32x16& P0, f32x16& P1, f32x16& N0, f32x16& N1, const int it) __attribute__((always_inline)) {
        if (it + 2 < NT) { if (DQ == 96) ATT_WAIT_BAR(3); else ATT_WAIT_BAR(2); } else ATT_WAIT_BAR(0);
        if (it + 3 < NT) ATT_DMA(it + 3);
        bf16x8 kf[2 * NKS];
        { const lds_cptr kp_ = kp0 + ((it + 1) & 3) * KSLOT;
#pragma unroll
          for (int d0 = 0; d0 < NKS; ++d0) { kf[2 * d0] = *(const LAS bf16x8*)(kp_ + d0 * 2048); kf[2 * d0 + 1] = *(const LAS bf16x8*)(kp_ + d0 * 2048 + 512); } }
        f32x2 sacc = {0.f, 0.f};
        ATT_SBAR();
#pragma unroll
        for (int d0 = 0; d0 < NKS; ++d0) {
            N0 = __builtin_amdgcn_mfma_f32_32x32x16_bf16(kf[2 * d0], qr[d0], d0 ? N0 : negm, 0, 0, 0); N1 = __builtin_amdgcn_mfma_f32_32x32x16_bf16(kf[2 * d0 + 1], qr[d0], d0 ? N1 : negm, 0, 0, 0);
            const int lo_ = (NKS == 6) ? CB6[d0] : CB4[d0], hi_ = (NKS == 6) ? CB6[d0 + 1] : CB4[d0 + 1];
#pragma unroll
            for (int i = 0; i < 32; i += 2) if (i >= lo_ && i < hi_) { if (i < 16) { P0[i] = __builtin_amdgcn_exp2f(P0[i]); P0[i + 1] = __builtin_amdgcn_exp2f(P0[i + 1]); sacc += (f32x2){P0[i], P0[i + 1]}; }
                else { P1[i - 16] = __builtin_amdgcn_exp2f(P1[i - 16]); P1[i - 15] = __builtin_amdgcn_exp2f(P1[i - 15]); sacc += (f32x2){P1[i - 16], P1[i - 15]}; } }
            ATT_SBAR();
        }
        const u32x4 pw0 = {cvtpk(P0[0], P0[1]), cvtpk(P0[2], P0[3]), cvtpk(P0[4], P0[5]), cvtpk(P0[6], P0[7])}, pw1 = {cvtpk(P0[8], P0[9]), cvtpk(P0[10], P0[11]), cvtpk(P0[12], P0[13]), cvtpk(P0[14], P0[15])};
        const u32x4 pw2 = {cvtpk(P1[0], P1[1]), cvtpk(P1[2], P1[3]), cvtpk(P1[4], P1[5]), cvtpk(P1[6], P1[7])};
        { const int vb = vb0 + (it & 3) * VSLOT; s16x4 vlo[2][4], vhi[2][4];
#pragma unroll
          for (int d0 = 0; d0 < 2; ++d0)
#pragma unroll
              for (int ks = 0; ks < 4; ++ks) {
                  asm volatile("ds_read_b64_tr_b16 %0,%1 offset:%c2" : "=&v"(vlo[d0][ks]) : "v"(vb), "i"(d0 * 4096 + ks * 1024) : "memory");
                  asm volatile("ds_read_b64_tr_b16 %0,%1 offset:%c2" : "=&v"(vhi[d0][ks]) : "v"(vb), "i"(d0 * 4096 + ks * 1024 + 512) : "memory"); }
          asm volatile("s_waitcnt lgkmcnt(0)" ::: "memory"); ATT_SBAR();
#define ATT_VF(d, k) (bf16x8){vlo[d][k][0], vlo[d][k][1], vlo[d][k][2], vlo[d][k][3], vhi[d][k][0], vhi[d][k][1], vhi[d][k][2], vhi[d][k][3]}
          o[0] = __builtin_amdgcn_mfma_f32_32x32x16_bf16(__builtin_bit_cast(bf16x8, pw0), ATT_VF(0, 0), o[0], 0, 0, 0); o[1] = __builtin_amdgcn_mfma_f32_32x32x16_bf16(__builtin_bit_cast(bf16x8, pw0), ATT_VF(1, 0), o[1], 0, 0, 0);
#pragma unroll
          for (int i = 8; i < 12; i += 2) { P1[i] = __builtin_amdgcn_exp2f(P1[i]); P1[i + 1] = __builtin_amdgcn_exp2f(P1[i + 1]); sacc += (f32x2){P1[i], P1[i + 1]}; }
          ATT_MASK(N0, N1, it + 1); ATT_SBAR();
          o[0] = __builtin_amdgcn_mfma_f32_32x32x16_bf16(__builtin_bit_cast(bf16x8, pw1), ATT_VF(0, 1), o[0], 0, 0, 0); o[1] = __builtin_amdgcn_mfma_f32_32x32x16_bf16(__builtin_bit_cast(bf16x8, pw1), ATT_VF(1, 1), o[1], 0, 0, 0);
#pragma unroll
          for (int i = 12; i < 16; i += 2) { P1[i] = __builtin_amdgcn_exp2f(P1[i]); P1[i + 1] = __builtin_amdgcn_exp2f(P1[i + 1]); sacc += (f32x2){P1[i], P1[i + 1]}; }
          const u32x4 pw3 = {cvtpk(P1[8], P1[9]), cvtpk(P1[10], P1[11]), cvtpk(P1[12], P1[13]), cvtpk(P1[14], P1[15])};
          l_reg += sacc[0] + sacc[1];
          ATT_SBAR();
          o[0] = __builtin_amdgcn_mfma_f32_32x32x16_bf16(__builtin_bit_cast(bf16x8, pw2), ATT_VF(0, 2), o[0], 0, 0, 0); o[1] = __builtin_amdgcn_mfma_f32_32x32x16_bf16(__builtin_bit_cast(bf16x8, pw2), ATT_VF(1, 2), o[1], 0, 0, 0);
          float ra = vmax3(N0[0], N1[0], N0[1]);
#pragma unroll
          for (int r = 1; r < 8; ++r) ra = vmax3(ra, N1[r], N0[r < 7 ? r + 1 : r]);
          ATT_SBAR();
          o[0] = __builtin_amdgcn_mfma_f32_32x32x16_bf16(__builtin_bit_cast(bf16x8, pw3), ATT_VF(0, 3), o[0], 0, 0, 0); o[1] = __builtin_amdgcn_mfma_f32_32x32x16_bf16(__builtin_bit_cast(bf16x8, pw3), ATT_VF(1, 3), o[1], 0, 0, 0);
#pragma unroll
          for (int r = 8; r < 16; ++r) ra = vmax3(ra, N0[r], N1[r]);
#undef ATT_VF
          auto rr = __builtin_amdgcn_permlane32_swap(__float_as_uint(ra), __float_as_uint(ra), false, false); const float rm = fmaxf(__uint_as_float(rr[0]), __uint_as_float(rr[1]));
          ATT_SBAR();
          if (it + 1 < NT) ATT_RESCALE_N(rm, N0, N1); }
    };
    for (int it = 0; it < NT; it += 2) { step(p0, p1, n0, n1v, it); if (it + 1 < NT) step(n0, n1v, p0, p1, it + 1); }
#undef ATT_MASK
#undef ATT_RESCALE
#undef ATT_RESCALE_N
    { auto rr = __builtin_amdgcn_permlane32_swap(__float_as_uint(l_reg), __float_as_uint(l_reg), false, false); l_reg = __uint_as_float(rr[0]) + __uint_as_float(rr[1]); }
    if (hi == 0) wsf[32 + r32] = l_reg;
    asm volatile("s_waitcnt lgkmcnt(0)" ::: "memory");
    float rli[16];
#pragma unroll
    for (int r = 0; r < 16; ++r) rli[r] = __builtin_amdgcn_rcpf(wsf[32 + crow(r, hi)]);
    { LAS bf16* stg = (LAS bf16*)(lds + LOST) + wid * 2048;
#pragma unroll
      for (int r = 0; r < 16; ++r) { const int orow = crow(r, hi);
#pragma unroll
          for (int d0 = 0; d0 < 2; ++d0) stg[orow * 64 + d0 * 32 + r32] = (bf16)(cvtpk(o[d0][r] * rli[r], 0.f) & 0xffffu); }
      asm volatile("s_waitcnt lgkmcnt(0)" ::: "memory");
#pragma unroll
      for (int i = 0; i < 4; ++i) { const int row = i * 8 + (lane >> 3), ch = lane & 7; const u32x4 v = *(const LAS u32x4*)(stg + row * 64 + ch * 8); *(u32x4*)(Ow + (size_t)row * D + ch * 8) = v; } }
    __builtin_amdgcn_s_setprio(0);
    asm volatile("s_waitcnt lgkmcnt(0)\n\ts_barrier" ::: "memory");
#undef ATT_TILE
#undef ATT_DMA
#undef ATT_WAIT_BAR
#undef ATT_QK
}
#undef ATT_SBAR
}

__device__ __forceinline__ void row_load(const float* src, int lane, f32x4 (&v)[8]) {
#pragma unroll
    for (int j = 0; j < 8; ++j) v[j] = *(const f32x4*)(src + 4 * lane + 256 * j);
}
__device__ __forceinline__ void row_load_bf(const bf16* src, int lane, f32x4 (&v)[8]) {
#pragma unroll
    for (int j = 0; j < 8; ++j) { const u32x2 w = *(const u32x2*)(src + 4 * lane + 256 * j); v[j] = (f32x4){bf_lo(w.x), bf_hi(w.x), bf_lo(w.y), bf_hi(w.y)}; }
}
__device__ __forceinline__ float row_ssq(const f32x4 (&v)[8]) {
    float s = 0.f;
#pragma unroll
    for (int j = 0; j < 8; ++j) s += (v[j][0] * v[j][0] + v[j][1] * v[j][1]) + (v[j][2] * v[j][2] + v[j][3] * v[j][3]);
    return wave_sum(s);
}
__device__ __forceinline__ void row_norm_mod(f32x4 (&v)[8], int lane, const float* g, const float* sh, const float* sc, bf16* dst) {
    const float rstd = rsqrtf(row_ssq(v) * (1.0f / D) + EPS);
#pragma unroll
    for (int j = 0; j < 8; ++j) { const int c = 4 * lane + 256 * j; const f32x4 gg = *(const f32x4*)(g + c), s1 = *(const f32x4*)(sc + c), s0 = *(const f32x4*)(sh + c);
        v[j] = v[j] * rstd * gg * (s1 + 1.0f) + s0; *(u32x2*)(dst + c) = pack4(v[j]); }
}

template <class RowMap>
__device__ __forceinline__ void transpose_item(const float* W, int N, const float* gk, bf16* WT, int ldk, int kdst0, LAS float* scr, int kb, int nb, int lane, const RowMap& rmap) {
    const int k0 = 64 * kb, n0 = 32 * nb;
    float wv[32];
    { const float* src = W + (size_t)(k0 + (lane >> 5)) * N + n0 + (lane & 31);
#pragma unroll
      for (int i = 0; i < 32; ++i) wv[i] = src[(size_t)(2 * i) * N]; }
    if (gk) { const float* gs = gk + k0 + (lane >> 5);
#pragma unroll
      for (int i = 0; i < 32; ++i) wv[i] *= gs[2 * i]; }
#pragma unroll
    for (int i = 0; i < 32; ++i) scr[(2 * i + (lane >> 5)) * 33 + (lane & 31)] = wv[i];
    asm volatile("s_waitcnt lgkmcnt(0)" ::: "memory");
    const int c = lane & 7;
#pragma unroll
    for (int j = 0; j < 4; ++j) { const int n = (lane >> 3) + 8 * j; const LAS float* s = scr + (8 * c) * 33 + n;
        u32x4 o; o.x = cvtpk(s[0 * 33], s[1 * 33]); o.y = cvtpk(s[2 * 33], s[3 * 33]); o.z = cvtpk(s[4 * 33], s[5 * 33]); o.w = cvtpk(s[6 * 33], s[7 * 33]);
        *(u32x4*)(WT + (size_t)rmap(n0 + n) * ldk + kdst0 + k0 + 8 * c) = o; }
    asm volatile("s_waitcnt lgkmcnt(0)" ::: "memory");
}
struct MapInMain { __device__ __forceinline__ int operator()(int s) const {
    if (s < 1536) return s;
    if (s < 2176) { const int q = s - 1536, head = q >> 6, i = q & 63, sh = i >> 5, ii = i & 31; return 1536 + head * 64 + 8 * (ii >> 2) + 4 * sh + (ii & 3); }
    if (s < 2304) return s;
    if (s < 3328) return s - 512;
    if (s < 3584) return s - 512;
    { const int i = s - 3584, sh = i >> 4, ii = i & 15; return 3072 + 8 * (ii >> 2) + 4 * sh + (ii & 3); } } };
struct MapUq { __device__ __forceinline__ int operator()(int s) const { const int head = s / 96, w = s - head * 96; if (w < 64) return s; const int i = w - 64, sh = i >> 4, ii = i & 15; return head * 96 + 64 + 8 * (ii >> 2) + 4 * sh + (ii & 3); } };
struct MapOff { int off; __device__ __forceinline__ int operator()(int s) const { return off + s; } };
struct MapGU { int off; __device__ __forceinline__ int operator()(int s) const { return ((s >> 7) << 8) + off + (s & 127); } };
#ifndef PROBE_DUP
#define PROBE_DUP 0
#endif
__device__ __forceinline__ int wave_isum(int v) {
#pragma unroll
    for (int o = 1; o < 64; o <<= 1) v += __shfl_xor(v, o);
    return v;
}
__device__ __forceinline__ int block_isum(int v, LAS int* red, int slot, int wave, int lane) {
    const int w = wave_isum(v);
    if (lane == 0) red[slot * 8 + wave] = w;
    __syncthreads();
    int s = 0;
#pragma unroll
    for (int i = 0; i < 8; ++i) s += red[slot * 8 + i];
    return s;
}
__device__ __forceinline__ int block_exscan(int v, LAS int* red, int slot, int wave, int lane) {
    int inc = v;
#pragma unroll
    for (int o = 1; o < 64; o <<= 1) { const int y = __shfl_up(inc, o); if (lane >= o) inc += y; }
    if (lane == 63) red[slot * 8 + wave] = inc;
    __syncthreads();
    int base = 0;
#pragma unroll
    for (int i = 0; i < 8; ++i) base += (i < wave) ? red[slot * 8 + i] : 0;
    return base + inc - v;
}

__device__ __forceinline__ void topk_task(LAS int* red, int set, int e, const float* AFF, int* TOK, int* POS) {
    const int tid = threadIdx.x, lane = tid & 63, wave = tid >> 6;
    const bool lat = set < 4; const int N = lat ? SEQ : CTXL, cap = lat ? CAPL : CAPC, tok0 = lat ? set * SEQ : TL + (set - 4) * CTXL;
    const int rowbase = e * EROWS + (lat ? set * CAPL : NB * CAPL + (set - 4) * CAPC);
    unsigned u[8];
#pragma unroll
    for (int i = 0; i < 8; ++i) { const int idx = tid * 8 + i; u[i] = idx < N ? __float_as_uint(AFF[(size_t)(tok0 + idx) * 16 + e]) + 1u : 0u; }
    unsigned lo = 1u, hi = 0x7f800002u; int it = 0;
    while (hi - lo > 1u) { const unsigned mid = lo + ((hi - lo) >> 1); int c = 0;
#pragma unroll
        for (int i = 0; i < 8; ++i) c += (u[i] >= mid) ? 1 : 0;
        const int tot = block_isum(c, red, it & 1, wave, lane); ++it;
        if (tot >= cap) lo = mid; else hi = mid; }
    const unsigned Tv = lo; int ngt = 0, neq = 0;
#pragma unroll
    for (int i = 0; i < 8; ++i) { ngt += (u[i] > Tv) ? 1 : 0; neq += (u[i] == Tv) ? 1 : 0; }
    const int cgt = block_isum(ngt, red, it & 1, wave, lane); ++it;
    const int need = cap - cgt;
    int eqb = block_exscan(neq, red, it & 1, wave, lane); ++it;
    int nsel = 0; bool sel[8];
#pragma unroll
    for (int i = 0; i < 8; ++i) { sel[i] = (u[i] > Tv) || (u[i] == Tv && eqb < need); if (u[i] == Tv) ++eqb; nsel += sel[i] ? 1 : 0; }
    int slot = block_exscan(nsel, red, it & 1, wave, lane); ++it;
#pragma unroll
    for (int i = 0; i < 8; ++i) { const int idx = tid * 8 + i; if (idx < N) { int p = -1; if (sel[i]) { p = rowbase + slot; ++slot; TOK[p] = tok0 + idx; } POS[(size_t)(tok0 + idx) * 16 + e] = p; } }
    __syncthreads();
}

struct Args { const float* in[22]; float* out; unsigned char* ws; };
enum { I_X = 0, I_C, I_CTX, I_CCTX, I_ADAW, I_ADAB, I_N1G, I_N2G, I_WIN, I_CONVW, I_SINK, I_QNG, I_WUQ, I_KVNG, I_WUKV, I_ONG, I_WOUT, I_WR, I_WG, I_WU, I_WD, I_FNG };

constexpr int MOE_PER_LAYER = 3 * NE * 2048, MOE_SLACK_ITEMS = MOE_PER_LAYER;
constexpr int MOE_P0_SHARE_L = MOE_PER_LAYER - MOE_SLACK_ITEMS;
struct MoeIt { const float* src; bf16* dst; int which; };
__device__ __forceinline__ MoeIt moe_item(unsigned char* ws, LAS unsigned char* lds, int g, int lane) {
    const int l = g / (3 * NE * 2048); int r = g - l * (3 * NE * 2048); const int which = r / (NE * 2048); r -= which * (NE * 2048); const int e = r >> 11; r &= 2047; const int kb = r >> 6, nb = r & 63;
    const float* base = which == 0 ? IN(I_WG) : which == 1 ? IN(I_WU) : IN(I_WD);
    MoeIt m; m.which = which;
    m.src = base + ((size_t)(l * NE + e) * D + 64 * kb + (lane >> 3)) * FF + 32 * nb + 4 * (lane & 7);
    bf16* d = which < 2 ? (bf16*)(ws + WS_WGU) + (size_t)(l * NE + e) * 2 * FF * D : (bf16*)(ws + WS_WD) + (size_t)(l * NE + e) * D * FF;
    const int c = lane & 7, n = 32 * nb + (lane >> 3);
    const int row = which < 2 ? ((n >> 7) << 8) + which * 128 + (n & 127) : n;
    m.dst = d + (size_t)row * D + 64 * kb + 8 * c; return m;
}
constexpr int MOE_SLOT = 8 * 1040, MOE_WAVE_LDS = 2 * MOE_SLOT;
__device__ __forceinline__ void moe_dma(const MoeIt& m, unsigned slot_lds, int lane) {
    const float* s = m.src;
#pragma unroll
    for (int i = 0; i < 8; ++i) att::glds16(s + (size_t)(8 * i) * FF, (unsigned)__builtin_amdgcn_readfirstlane(slot_lds + i * 1040));
}
template <bool STORE = true> __device__ __forceinline__ void moe_finish(const MoeIt& m, LAS const float* slot, int lane) {
    const int c = lane & 7;
#pragma unroll
    for (int j = 0; j < 4; ++j) { const int n = (lane >> 3) + 8 * j; const LAS float* s = slot + c * 260 + n;
        u32x4 o; o.x = cvtpk(s[0], s[32]); o.y = cvtpk(s[64], s[96]); o.z = cvtpk(s[128], s[160]); o.w = cvtpk(s[192], s[224]);
        if (STORE) *(u32x4*)(m.dst + (size_t)(8 * j) * D) = o; else asm volatile("" :: "v"(o)); }
}
template <bool STORE = true> __device__ __forceinline__ void moe_convert(unsigned char* ws, LAS unsigned char* lds, int first, int stride, int end, int wave, int lane) {
    LAS unsigned char* base = lds + wave * MOE_WAVE_LDS; const unsigned b0 = (unsigned)(uintptr_t)base;
    int g = first; if (g >= end) return;
    MoeIt ma = moe_item(ws, lds, g, lane), mb = ma; moe_dma(ma, b0, lane);
    { int gn = g + stride;
      if (gn < end) { mb = moe_item(ws, lds, gn, lane); moe_dma(mb, b0 + MOE_SLOT, lane); asm volatile("s_waitcnt vmcnt(8)" ::: "memory"); } else asm volatile("s_waitcnt vmcnt(0)" ::: "memory");
      moe_finish<STORE>(ma, (LAS const float*)base, lane); asm volatile("s_waitcnt lgkmcnt(0)" ::: "memory");
      if (gn >= end) { asm volatile("s_waitcnt vmcnt(0)" ::: "memory"); return; } g = gn; }
    for (;;) {
        int gn = g + stride;
        if (gn < end) { ma = moe_item(ws, lds, gn, lane); moe_dma(ma, b0, lane); asm volatile("s_waitcnt vmcnt(12)" ::: "memory"); } else asm volatile("s_waitcnt vmcnt(0)" ::: "memory");
        moe_finish<STORE>(mb, (LAS const float*)(base + MOE_SLOT), lane); asm volatile("s_waitcnt lgkmcnt(0)" ::: "memory");
        if (gn >= end) break; g = gn;
        gn = g + stride;
        if (gn < end) { mb = moe_item(ws, lds, gn, lane); moe_dma(mb, b0 + MOE_SLOT, lane); asm volatile("s_waitcnt vmcnt(12)" ::: "memory"); } else asm volatile("s_waitcnt vmcnt(0)" ::: "memory");
        moe_finish<STORE>(ma, (LAS const float*)base, lane); asm volatile("s_waitcnt lgkmcnt(0)" ::: "memory");
        if (gn >= end) break; g = gn;
    }
    asm volatile("s_waitcnt vmcnt(0)" ::: "memory");
}

__device__ __forceinline__ float bf_el(const u32x4& w, int e) { const unsigned x = w[e >> 1]; return (e & 1) ? bf_hi(x) : bf_lo(x); }
__device__ __forceinline__ void fnet_fold_row(const bf16* g, bf16* o, int lane) {
#pragma unroll
    for (int i = 0; i < 4; ++i) { const int k0 = 8 * (lane + 64 * i);
#pragma unroll
        for (int part = 0; part < 2; ++part) { const bf16* src = g + part * SEQ; const float sg = part ? -1.0f : 1.0f;
            const u32x4 fw = *(const u32x4*)(src + k0), rv = *(const u32x4*)(src + SEQ - k0 - 8);
            float e0 = 0.f; if (k0 > 0) e0 = __uint_as_float((unsigned)src[SEQ - k0] << 16);
            float v[8];
            v[0] = bf_el(fw, 0) + sg * e0;
#pragma unroll
            for (int q = 1; q < 8; ++q) v[q] = bf_el(fw, q) + sg * bf_el(rv, 8 - q);
            if (part == 1 && k0 == 0) v[0] = __uint_as_float((unsigned)g[SEQ / 2] << 16);
            const u32x4 ov = {cvtpk(v[0], v[1]), cvtpk(v[2], v[3]), cvtpk(v[4], v[5]), cvtpk(v[6], v[7])};
            *(u32x4*)(o + part * (SEQ / 2) + k0) = ov; } }
}

__device__ __forceinline__ void p0_prologue(unsigned char* ws, LAS unsigned char* lds, int gw, int NGW, int wave, int lane_) {
    LAS float* scr = (LAS float*)(lds + wave * MOE_WAVE_LDS);
    constexpr int A1 = 32 * 97, A2 = 8 * 24, A3 = 4 * 32, A4 = 32 * 64, PERL = A1 + A2 + A3 + A4;
    constexpr int NZ = 224 + 768 + 1024, NFOLD = 256, NADA = 2 * 48 * ADA_KC;
    int lane = lane_;
#define P0_SPLIT() asm volatile("" : "+v"(lane))
#define P0REP(k) for (int prep_ = 0; prep_ < ((PROBE_DUP == (k)) ? 2 : 1); ++prep_)
    for (int l = 0; l < 2; ++l) moe_convert(ws, lds, l * MOE_PER_LAYER + MOE_SLACK_ITEMS + gw, NGW, (l + 1) * MOE_PER_LAYER, wave, lane);
    __syncthreads();
    P0_SPLIT();
    P0REP(31) for (int it = gw; it < NADA; it += NGW) {
        int r = it; const int l = r / (48 * ADA_KC); r -= l * (48 * ADA_KC); const int jg = r / ADA_KC, kc = r - jg * ADA_KC, k0 = kc * (D / ADA_KC);
        const float* W = IN(I_ADAW) + (size_t)l * D * 6 * D + jg * 256 + lane * 4; const float* cin = IN(I_C); const float* ccin = IN(I_CCTX);
        f32x4 acc[5];
#pragma unroll
        for (int q = 0; q < 5; ++q) acc[q] = (f32x4){0.f, 0.f, 0.f, 0.f};
        for (int sub = 0; sub < D / ADA_KC / 64; ++sub) { float sv[5];
#pragma unroll
            for (int q = 0; q < 5; ++q) { const float cv = q < 4 ? cin[q * D + k0 + sub * 64 + lane] : ccin[k0 + sub * 64 + lane]; sv[q] = silu_f(cv); }
#pragma unroll 8
            for (int kk = 0; kk < 64; ++kk) { const f32x4 w4 = *(const f32x4*)(W + (size_t)(k0 + sub * 64 + kk) * 6 * D);
#pragma unroll
                for (int q = 0; q < 5; ++q) acc[q] += w4 * __shfl(sv[q], kk); } }
        float* MP = (float*)(ws + WS_MODP) + ((size_t)kc * 2 + l) * 5 * 6 * D + jg * 256 + lane * 4;
#pragma unroll
        for (int q = 0; q < 5; ++q) *(f32x4*)(MP + q * 6 * D) = acc[q];
    }
    P0_SPLIT();
    P0REP(32) for (int it = NGW - 1 - gw; it < 2 * NFOLD; it += NGW) {
        int r = it; const int l = r / NFOLD; r -= l * NFOLD; const int kb = r >> 3, g = r & 7, k0 = 64 * kb;
        const float* W = IN(I_WIN) + (size_t)l * D * INC + 2304 + g * 64;
        float w[64];
#pragma unroll
        for (int i = 0; i < 64; ++i) w[i] = W[(size_t)(k0 + i) * INC + lane];
#pragma unroll
        for (int i = 0; i < 64; ++i) scr[i * 64 + (lane ^ i)] = w[i];
        asm volatile("s_waitcnt lgkmcnt(0)" ::: "memory");
#pragma unroll
        for (int c = 0; c < 64; ++c) w[c] = scr[lane * 64 + (c ^ lane)];
        float tc, tsn; sincospif((float)lane * (1.0f / 32.0f), &tsn, &tc); tc *= 0.125f; tsn *= 0.125f;
        bf16* WF = (bf16*)(ws + WS_WIN) + ((size_t)l * (NIN_MAIN + NIN_F) + NIN_MAIN) * D;
        for (int cp = 0; cp <= 32; ++cp) { float ac = 0.f, as = 0.f;
#pragma unroll
            for (int c = 0; c < 64; ++c) { const int idx = (c * cp) & 63;
                ac += w[c] * __builtin_bit_cast(float, __builtin_amdgcn_readlane(__builtin_bit_cast(int, tc), idx)); as += w[c] * __builtin_bit_cast(float, __builtin_amdgcn_readlane(__builtin_bit_cast(int, tsn), idx)); }
            WF[(size_t)(g * 64 + cp) * D + k0 + lane] = (bf16)(cvtpk(ac, 0.f) & 0xffffu); if (cp >= 1 && cp <= 31) WF[(size_t)(g * 64 + 32 + cp) * D + k0 + lane] = (bf16)(cvtpk(as, 0.f) & 0xffffu); }
        asm volatile("s_waitcnt lgkmcnt(0)" ::: "memory");
    }
    P0_SPLIT();
    P0REP(33) for (int n = gw; n < SEQ; n += NGW) {
        bf16* row = (bf16*)(ws + WS_DN) + (size_t)n * SEQ;
        for (int j = 0; j < 4; ++j) { const int m0 = (j * 64 + lane) * 8; float c[8], s[8];
#pragma unroll
            for (int q = 0; q < 8; ++q) { const float rv = (float)((n * (m0 + q)) & (SEQ - 1)) * (1.0f / 4096.0f); c[q] = __builtin_amdgcn_cosf(rv) * (1.0f / 64.0f); s[q] = __builtin_amdgcn_sinf(rv) * (-1.0f / 64.0f); }
            if (m0 == 0) s[0] = (n & 1) ? (-1.0f / 64.0f) : (1.0f / 64.0f);
            u32x4 oc = {cvtpk(c[0], c[1]), cvtpk(c[2], c[3]), cvtpk(c[4], c[5]), cvtpk(c[6], c[7])}, os = {cvtpk(s[0], s[1]), cvtpk(s[2], s[3]), cvtpk(s[4], s[5]), cvtpk(s[6], s[7])};
            *(u32x4*)(row + m0) = oc; *(u32x4*)(row + SEQ / 2 + m0) = os; }
    }
    P0_SPLIT();
    P0REP(34) for (int it = gw; it < 2 * PERL; it += NGW) {
        const int l = it / PERL; int r = it - l * PERL;
        bf16* WIN = (bf16*)(ws + WS_WIN) + (size_t)l * (NIN_MAIN + NIN_F) * D; bf16* WUP = (bf16*)(ws + WS_WUP) + (size_t)l * NUP * KUP;
        if (r < A1) { const int kb = r / 97; int nb = r - kb * 97; if (nb >= 72) nb += 16; transpose_item(IN(I_WIN) + (size_t)l * D * INC, INC, nullptr, WIN, D, 0, scr, kb, nb, lane, MapInMain{}); continue; } r -= A1;
        if (r < A2) { transpose_item(IN(I_WUQ) + (size_t)l * 512 * 768, 768, IN(I_QNG) + l * 512, WUP, 512, 0, scr, r / 24, r % 24, lane, MapUq{}); continue; } r -= A2;
        if (r < A3) { transpose_item(IN(I_WUKV) + (size_t)l * 256 * 1024, 1024, IN(I_KVNG) + l * 256, WUP + 768 * 512, 256, 0, scr, r / 32, r % 32, lane, MapOff{0}); continue; } r -= A3;
        transpose_item(IN(I_WOUT) + (size_t)l * D * D, D, IN(I_ONG) + l * D, (bf16*)(ws + WS_WO) + (size_t)l * D * D, D, 0, scr, r / 64, r % 64, lane, MapOff{0});
    }
    P0_SPLIT();
    for (int it = gw; it < 2 * NZ; it += NGW) {
        int r = it; const int l = r / NZ; r -= l * NZ;
        bf16* WIN = (bf16*)(ws + WS_WIN) + (size_t)l * (NIN_MAIN + NIN_F) * D; bf16* WUP = (bf16*)(ws + WS_WUP) + (size_t)l * NUP * KUP;
        const u32x4 z = {0u, 0u, 0u, 0u};
        if (r < 224) { u32x4* p = (u32x4*)(WIN + (size_t)(3104 + r) * D);
#pragma unroll
            for (int j = 0; j < 4; ++j) p[lane + 64 * j] = z; }
        (void)WUP;
    }
    P0_SPLIT();
    for (int n = gw; n < SEQ; n += NGW) {
        const int prow = n >> 6, pcol = n & 63;
        if (lane < 48) { const bool sw = lane < 32; const int i = sw ? lane : lane - 32, nf = sw ? 16 : 8; const int j = i < nf ? i : i - nf; const float pos = i < nf ? (float)prow : (float)pcol;
            const float ang = pos * powf(10000.0f, -(float)j / (float)nf); f32x2 cs = {cosf(ang), sinf(ang)};
            if (sw) ((f32x2*)(ws + WS_ROPS))[n * 32 + i] = cs; else ((f32x2*)(ws + WS_ROPM))[n * 16 + i] = cs; }
    }
    P0_SPLIT();
    for (int k = gw; k < CTXL; k += NGW) { bf16* rowl = (bf16*)(ws + WS_DL) + (size_t)k * 2 * CTXL; const int m0 = lane * 8; float cv[8];
#pragma unroll
        for (int q = 0; q < 8; ++q) { const int m = m0 + q, rr = (k * (m & 255)) & 255; float s, cc; sincospif((float)rr * (1.0f / 128.0f), &s, &cc); cv[q] = (m < 256 ? cc : -s) * (1.0f / 16.0f); }
        u32x4 ov = {cvtpk(cv[0], cv[1]), cvtpk(cv[2], cv[3]), cvtpk(cv[4], cv[5]), cvtpk(cv[6], cv[7])}; *(u32x4*)(rowl + m0) = ov; }
#undef P0_SPLIT
#undef P0REP
}
#ifndef PROBE_DUP
#define PROBE_DUP 0
#endif
#ifndef MIX_S0
#define MIX_S0 3
#endif
#ifndef MOE_C0
#define MOE_C0 4
#endif
#define REP(k) for (int rep_ = 0; rep_ < ((PROBE_DUP == (k)) ? 2 : 1); ++rep_)
__global__ void __launch_bounds__(NTHR, 2) mega_fwd(Args args) {
    extern __shared__ __attribute__((aligned(16))) unsigned char lds_raw[];
    LAS unsigned char* lds = (LAS unsigned char*)lds_raw;
    const int tid0 = threadIdx.x, wave = __builtin_amdgcn_readfirstlane(tid0 >> 6);
    int tid = tid0, lane = tid0 & 63;
#define MODL (MOD + (size_t)l * 5 * 6 * D)
#define WINl ((const char*)(ws + WS_WIN) + (size_t)l * (NIN_MAIN + NIN_F) * D * 2)
#define LAUNDER() do { tid = threadIdx.x; asm volatile("" : "+v"(tid)); lane = tid & 63; unsigned long long w_ = (unsigned long long)args.ws; asm volatile("" : "+s"(w_)); ws = (unsigned char*)(GAS unsigned char*)w_; } while (0)
    const int G = gridDim.x, c = blockIdx.x, gw = c * NWAVES + wave, NGW = G * NWAVES;
    volatile LAS unsigned* MISC = (volatile LAS unsigned*)(lds + LDS_MISC);
    if (tid < 64) MISC[tid] = 0u;
    if (tid == 0) { LAS unsigned long long* at = (LAS unsigned long long*)(lds + LDS_ARGS);
#pragma unroll
        for (int i = 0; i < 22; ++i) at[i] = (unsigned long long)args.in[i];
        at[22] = (unsigned long long)args.out; }
    __syncthreads();
    unsigned char* ws = args.ws;
    (void)xcd_barrier_post((unsigned*)(ws + WS_CTL) + CW_BAR, MISC + 8);
#define GRID_BAR() do { XcdBarrier b_; b_.bar = (unsigned*)(args.ws + WS_CTL) + CW_BAR; b_.x = xb_xcc_id(); b_.st = (volatile LAS unsigned*)(lds + LDS_MISC) + 8; xcd_barrier(b_); } while (0)
#define MOD ((const float*)(ws + CTL_MOD))
#define X ((bf16*)(ws + WS_X))
#define H ((bf16*)(ws + WS_H))
#define PC ((bf16*)(ws + WS_PC))
#define SQ ((bf16*)(ws + WS_SQ))
#define KS ((bf16*)(ws + WS_KS))
#define VS ((bf16*)(ws + WS_VS))
#define MCQ ((bf16*)(ws + WS_MCQ))
#define QM ((bf16*)(ws + WS_QM))
#define KM ((bf16*)(ws + WS_KM))
#define VM ((bf16*)(ws + WS_VM))
#define GT ((bf16*)(ws + WS_GT))
#define GTC ((bf16*)(ws + WS_GTC))
#define YMIX ((bf16*)(ws + WS_YMIX))
#define SSQ ((float*)(ws + WS_SSQ))
#define AFF ((float*)(ws + WS_AFF))
#define POS ((int*)(ws + WS_POS))
#define TOK ((int*)(ws + WS_TOK))
#define ACT ((bf16*)(ws + WS_ACT))
#define Y ((bf16*)(ws + WS_Y))
#define ROPS ((const f32x2*)(ws + WS_ROPS))
#define ROPM ((const f32x2*)(ws + WS_ROPM))

    LAUNDER();
    p0_prologue(ws, lds, gw, NGW, wave, lane);
    GRID_BAR();
#if PROBE_DUP == 1
    LAUNDER(); p0_prologue(ws, lds, gw, NGW, wave, lane);
    GRID_BAR();
#endif
#if PROBE_DUP == 20
    for (int q = 0; q < 10; ++q) GRID_BAR();
#endif
#if PROBE_DUP == 18
    LAUNDER(); if ((c & 3) == 0) moe_convert(ws, lds, (c >> 2) * NWAVES + wave, 64 * NWAVES, 64 * NWAVES * 40, wave, lane);
    GRID_BAR();
#endif
#if PROBE_DUP == 19
    LAUNDER(); if ((c & 15) == 0) moe_convert(ws, lds, (c >> 4) * NWAVES + wave, 16 * NWAVES, 16 * NWAVES * 40, wave, lane);
    GRID_BAR();
#endif
    LAUNDER();
    for (int i = c * NTHR + tid; i < 2 * 5 * 6 * D; i += G * NTHR) { const int l = i / (5 * 6 * D), j = i % (6 * D); float s = IN(I_ADAB)[l * 6 * D + j];
#pragma unroll
        for (int kc = 0; kc < ADA_KC; ++kc) s += ((const float*)(ws + WS_MODP))[(size_t)kc * 2 * 5 * 6 * D + i];
        ((float*)(ws + CTL_MOD))[i] = s; }
    GRID_BAR();
    LAUNDER();
    REP(14) for (int t0 = gw; t0 < T; t0 += 2 * NGW) { const int t1 = (t0 + NGW < T) ? t0 + NGW : t0; f32x4 v0[8], v1[8];
        row_load(t0 < TL ? IN(I_X) + (size_t)t0 * D : IN(I_CTX) + (size_t)(t0 - TL) * D, lane, v0); row_load(t1 < TL ? IN(I_X) + (size_t)t1 * D : IN(I_CTX) + (size_t)(t1 - TL) * D, lane, v1);
        const float* m0 = MOD + mod_row(t0) * 6 * D; const float* m1 = MOD + mod_row(t1) * 6 * D;
        row_norm_mod(v0, lane, IN(I_N1G), m0, m0 + D, H + (size_t)t0 * D); row_norm_mod(v1, lane, IN(I_N1G), m1, m1 + D, H + (size_t)t1 * D); }
    GRID_BAR();

    for (int l = 0; l < 2; ++l) {
        const bool last = (l == 1); const int rows = last ? TL : T;
        LAUNDER();
        REP(2) { SchedInproj S{(const char*)H, WINl, WINl + (size_t)NIN_MAIN * D * 2, G, c}; EpiInproj E{ws};
          pg8::gemm_phase<false>(lds, D, D * 2, D * 2, S, E);
        GRID_BAR(); }
        LAUNDER();
        REP(3) { int cq = c; asm volatile("" : "+s"(cq)); const char* wupl = (const char*)(ws + WS_WUP) + (size_t)l * NUP * KUP * 2; EpiUp E{ws};
          { SchedPlain S{(const char*)MCQ, wupl, 68, 3, G, cq, KUP * 2, 512 * 2, 0}; pg8::gemm_phase<false>(lds, 512, KUP * 2, 512 * 2, S, E); }
          { const int cr = (cq + G - (204 % G)) % G;
            SchedPlain S{(const char*)(MCQ + 512), wupl + (size_t)768 * 512 * 2, 68, 4, G, cr, KUP * 2, 256 * 2, 1}; pg8::gemm_phase<false>(lds, 256, KUP * 2, 256 * 2, S, E); }
          LAUNDER();
          for (int task = gw; task < NB * 512; task += NGW) fnet_fold_row(GT + (size_t)task * 2 * SEQ, (bf16*)(ws + WS_GTF) + (size_t)task * SEQ, lane);
        GRID_BAR(); }
        LAUNDER();
        REP(4) {
        if (!last) { SchedFnetC S{(const char*)(ws + WS_DL), (const char*)GTC, c, G}; EpiFnetC E{YMIX}; pg8::gemm_phase<false>(lds, 2 * CTXL, 2 * CTXL * 2, 2 * CTXL * 2, S, E); }
        REP(11) { SchedFnet S{(const char*)(ws + WS_DN), (const char*)(ws + WS_GTF), c, G}; EpiFnet E{YMIX}; pg8::gemm_phase<false>(lds, SEQ, SEQ * 2, SEQ * 2, S, E); }
        {
            int cx = c; asm volatile("" : "+s"(cx));
            const bool tuned = (G == 256); const int x = cx & 7, li = cx >> 3; const int cls = tuned ? (li < 16 ? 0 : li < 24 ? 1 : 2) : 0;
            const int mbase = l * MOE_PER_LAYER, n0i = 1024 * MOE_C0, n12 = (MOE_PER_LAYER - n0i) / 2;
            if (tuned && cls == 1) { moe_convert(ws, lds, mbase + n0i + ((x * 8 + li - 16) * NWAVES + wave), 64 * NWAVES, mbase + n0i + n12, wave, lane); __syncthreads(); }
            const int nm = tuned ? 2 : (512 - c + G - 1) / G; const int kb = (li < 16) ? 2 * li : 32 + 2 * (li - 16);
            REP(12) for (int i = 0; i < nm; ++i) { const int k = kb + i; const int id = tuned ? (4 * x + (k >> 4)) * 16 + (k & 15) : c + i * G; if (id >= 512) break;
                const int bh = id >> 4, qb = id & 15, b = bh >> 3, h = bh & 7; const size_t r0 = (size_t)b * SEQ + qb * 256 + wave * 32;
                att::attn_unit<96, false>(lds, QM + r0 * 768 + h * 96, 768, KM + (size_t)b * KVR * 512 + h * 64, 512, (const bf16*)(ws + WS_KPE) + (size_t)b * KVR * 32, VM + (size_t)b * KVR * 512 + h * 64, 512, YMIX + r0 * D + 1536 + h * 64, 0, 64, 4, 0, -1e30f, 0.f); }
            const int ns = tuned ? (li < 16 ? MIX_S0 : 4 - MIX_S0) : (512 - c + G - 1) / G; const int sb = li < 16 ? MIX_S0 * li : 16 * MIX_S0 + (4 - MIX_S0) * (li - 16);
            REP(13) for (int i = 0; i < ns; ++i) { const int k = sb + i; const int id = tuned ? (4 * x + (k >> 4)) * 16 + (k & 15) : c + i * G; if (id >= 512) break;
                const int bh = id >> 4, qb = id & 15, b = bh >> 3, h = bh & 7; const size_t r0 = (size_t)b * SEQ + qb * 256 + wave * 32;
                const int a0 = (4 * qb - 2) < 0 ? 0 : 4 * qb - 2, a1 = (4 * qb + 6) > 64 ? 64 : 4 * qb + 6;
                att::attn_unit<64, true>(lds, SQ + r0 * 512 + h * 64, 512, KS + (size_t)b * KVR * 128 + (h >> 2) * 64, 128, nullptr, VS + (size_t)b * KVR * 128 + (h >> 2) * 64, 128, YMIX + r0 * D + 512 + h * 64,
                                         a0, a1 - a0, 4, qb * 256, IN(I_SINK)[l * 8 + h] * LOG2E, 1.f); }
            if (!last) {
                const int nc = tuned ? (li < 8 ? 1 : 0) : (64 - c + G - 1) / G;
                REP(23) for (int i = 0; i < nc; ++i) { const int id = tuned ? x * 8 + li : c + i * G; if (id >= 64) break;
                    const int bh = id & 31, b = bh >> 3, h = bh & 7; const size_t r0 = (size_t)TL + b * CTXL + wave * 32;
                    if (id < 32) att::attn_unit<96, false>(lds, QM + r0 * 768 + h * 96, 768, KM + (size_t)b * KVR * 512 + h * 64, 512, (const bf16*)(ws + WS_KPE) + (size_t)b * KVR * 32, VM + (size_t)b * KVR * 512 + h * 64, 512, YMIX + r0 * D + 1536 + h * 64, 0, 0, 4, 0, -1e30f, 0.f);
                    else att::attn_unit<64, false>(lds, SQ + r0 * 512 + h * 64, 512, KS + (size_t)b * KVR * 128 + (h >> 2) * 64, 128, nullptr, VS + (size_t)b * KVR * 128 + (h >> 2) * 64, 128, YMIX + r0 * D + 512 + h * 64,
                                                   0, 0, 4, 0, IN(I_SINK)[l * 8 + h] * LOG2E, 1.f); } }
            LAUNDER();
            if (!tuned) moe_convert(ws, lds, mbase + gw, NGW, mbase + MOE_PER_LAYER, wave, lane);
            else if (cls == 0) moe_convert(ws, lds, mbase + ((x * 16 + li) * NWAVES + wave), 128 * NWAVES, mbase + n0i, wave, lane);
            else if (cls == 2) moe_convert(ws, lds, mbase + n0i + n12 + ((x * 8 + li - 24) * NWAVES + wave), 64 * NWAVES, mbase + MOE_PER_LAYER, wave, lane);
        }
        __syncthreads();
        LAUNDER();
        {
            const float* cw = IN(I_CONVW) + l * 3 * 512;
            const bool cv0 = (G == 256); const int t0c = cv0 ? (((c >> 3) < 16) ? ((c & 7) * 16 + (c >> 3)) * NWAVES + wave : rows) : gw, tsc = cv0 ? 128 * NWAVES : NGW;
            REP(21) for (int t = t0c; t < rows; t += tsc) { int pos, len; if (t < TL) { pos = t & (SEQ - 1); len = SEQ; } else { pos = (t - TL) & (CTXL - 1); len = CTXL; }
                const bf16* pr = PC + (size_t)t * 1536 + 8 * lane; float y[8];
                const u32x4 cb = *(const u32x4*)pr, cc = *(const u32x4*)(pr + 512), ch = *(const u32x4*)(pr + 1024);
                const f32x4 w1a = *(const f32x4*)(cw + 512 + 8 * lane), w1b = *(const f32x4*)(cw + 512 + 8 * lane + 4);
#pragma unroll
                for (int q = 0; q < 4; ++q) { y[2 * q] = bf_lo(cc[q]) * bf_lo(ch[q]) * (q < 2 ? w1a[2 * q] : w1b[2 * q - 4]); y[2 * q + 1] = bf_hi(cc[q]) * bf_hi(ch[q]) * (q < 2 ? w1a[2 * q + 1] : w1b[2 * q - 3]); }
                if (pos > 0) { const u32x4 c2 = *(const u32x4*)(pr - 1536 + 512), h2 = *(const u32x4*)(pr - 1536 + 1024); const f32x4 wa = *(const f32x4*)(cw + 8 * lane), wb = *(const f32x4*)(cw + 8 * lane + 4);
#pragma unroll
                    for (int q = 0; q < 4; ++q) { y[2 * q] += bf_lo(c2[q]) * bf_lo(h2[q]) * (q < 2 ? wa[2 * q] : wb[2 * q - 4]); y[2 * q + 1] += bf_hi(c2[q]) * bf_hi(h2[q]) * (q < 2 ? wa[2 * q + 1] : wb[2 * q - 3]); } }
                if (pos < len - 1) { const u32x4 c2 = *(const u32x4*)(pr + 1536 + 512), h2 = *(const u32x4*)(pr + 1536 + 1024); const f32x4 wa = *(const f32x4*)(cw + 1024 + 8 * lane), wb = *(const f32x4*)(cw + 1024 + 8 * lane + 4);
#pragma unroll
                    for (int q = 0; q < 4; ++q) { y[2 * q] += bf_lo(c2[q]) * bf_lo(h2[q]) * (q < 2 ? wa[2 * q] : wb[2 * q - 4]); y[2 * q + 1] += bf_hi(c2[q]) * bf_hi(h2[q]) * (q < 2 ? wa[2 * q + 1] : wb[2 * q - 3]); } }
                u32x4 o;
#pragma unroll
                for (int q = 0; q < 4; ++q) o[q] = cvtpk(bf_lo(cb[q]) * y[2 * q], bf_hi(cb[q]) * y[2 * q + 1]);
                *(u32x4*)(YMIX + (size_t)t * D + 8 * lane) = o; }
        }
        LAUNDER();
        GRID_BAR(); }
        LAUNDER();
        for (int t0 = gw; t0 < rows; t0 += 2 * NGW) { const int t1 = (t0 + NGW < rows) ? t0 + NGW : t0; bf16* y0 = YMIX + (size_t)t0 * D + 8 * lane; bf16* y1 = YMIX + (size_t)t1 * D + 8 * lane;
            u32x4 va[4], vb[4];
#pragma unroll
            for (int g = 0; g < 4; ++g) { va[g] = *(const u32x4*)(y0 + 512 * g); vb[g] = *(const u32x4*)(y1 + 512 * g); }
#pragma unroll
            for (int g = 0; g < 4; ++g) { float fa[8], fb[8]; float sa = 0.f, sb = 0.f;
#pragma unroll
                for (int q = 0; q < 4; ++q) { fa[2 * q] = bf_lo(va[g][q]); fa[2 * q + 1] = bf_hi(va[g][q]); sa += fa[2 * q] * fa[2 * q] + fa[2 * q + 1] * fa[2 * q + 1];
                                              fb[2 * q] = bf_lo(vb[g][q]); fb[2 * q + 1] = bf_hi(vb[g][q]); sb += fb[2 * q] * fb[2 * q] + fb[2 * q + 1] * fb[2 * q + 1]; }
                const float ra = rsqrtf(wave_sum(sa) * (1.0f / 512.0f) + EPS), rb = rsqrtf(wave_sum(sb) * (1.0f / 512.0f) + EPS); u32x4 oa, ob;
#pragma unroll
                for (int q = 0; q < 4; ++q) { oa[q] = cvtpk(fa[2 * q] * ra, fa[2 * q + 1] * ra); ob[q] = cvtpk(fb[2 * q] * rb, fb[2 * q + 1] * rb); }
                *(u32x4*)(y0 + 512 * g) = oa; if (t1 != t0) *(u32x4*)(y1 + 512 * g) = ob; } }
        GRID_BAR();
        LAUNDER();
        for (int rep5 = 0; rep5 < ((PROBE_DUP == 5 && l == 0) ? 2 : 1); ++rep5) { SchedPlain S{(const char*)YMIX, (const char*)(ws + WS_WO) + (size_t)l * D * D * 2, rows / 256, 8, G, c, D * 2, D * 2, 0};
          EpiOut E{IN(I_X), IN(I_CTX), l == 0 ? (const bf16*)nullptr : (const bf16*)X, X, MODL};
          pg8::gemm_phase<false>(lds, D, D * 2, D * 2, S, E);
        GRID_BAR(); }
        LAUNDER();
        REP(6) {
        { LAS float* WT = (LAS float*)lds; const float* wr = IN(I_WR) + (size_t)l * D * 16;
          for (int i = tid; i < D * 4; i += NTHR) { const int k = i >> 2, q = i & 3; const f32x4 w = *(const f32x4*)(wr + k * 16 + q * 4);
              WT[(4 * q + 0) * D + k] = w[0]; WT[(4 * q + 1) * D + k] = w[1]; WT[(4 * q + 2) * D + k] = w[2]; WT[(4 * q + 3) * D + k] = w[3]; }
          __syncthreads();
          for (int t0 = gw; t0 < rows; t0 += 2 * NGW) { const int t1 = (t0 + NGW < rows) ? t0 + NGW : t0; f32x4 v0[8], v1[8];
              row_load_bf(X + (size_t)t0 * D, lane, v0); row_load_bf(X + (size_t)t1 * D, lane, v1);
              const float* m0 = MODL + mod_row(t0) * 6 * D; const float* m1 = MODL + mod_row(t1) * 6 * D;
              row_norm_mod(v0, lane, IN(I_N2G) + l * D, m0 + 3 * D, m0 + 4 * D, H + (size_t)t0 * D); row_norm_mod(v1, lane, IN(I_N2G) + l * D, m1 + 3 * D, m1 + 4 * D, H + (size_t)t1 * D);
              float lg0[16], lg1[16];
#pragma unroll
              for (int e = 0; e < 16; ++e) { float s0 = 0.f, s1 = 0.f;
#pragma unroll
                  for (int j = 0; j < 8; ++j) { const f32x4 w = *(const LAS f32x4*)(WT + e * D + 4 * lane + 256 * j);
                      s0 += (v0[j][0] * w[0] + v0[j][1] * w[1]) + (v0[j][2] * w[2] + v0[j][3] * w[3]); s1 += (v1[j][0] * w[0] + v1[j][1] * w[1]) + (v1[j][2] * w[2] + v1[j][3] * w[3]); }
                  lg0[e] = wave_sum(s0); lg1[e] = wave_sum(s1); asm volatile("" ::: "memory"); }
              float mx0 = lg0[0], mx1 = lg1[0];
#pragma unroll
              for (int e = 1; e < 16; ++e) { mx0 = fmaxf(mx0, lg0[e]); mx1 = fmaxf(mx1, lg1[e]); }
              float den0 = 0.f, mine0 = 0.f, den1 = 0.f, mine1 = 0.f;
#pragma unroll
              for (int e = 0; e < 16; ++e) { lg0[e] = __expf(lg0[e] - mx0); den0 += lg0[e]; mine0 = (lane == e) ? lg0[e] : mine0; lg1[e] = __expf(lg1[e] - mx1); den1 += lg1[e]; mine1 = (lane == e) ? lg1[e] : mine1; }
              if (lane < 16) { AFF[(size_t)t0 * 16 + lane] = mine0 / den0; if (t1 != t0) AFF[(size_t)t1 * 16 + lane] = mine1 / den1; } }
          __syncthreads(); }
        GRID_BAR(); }
        LAUNDER();
        REP(7) {
        { const int ntask = last ? 64 : 128; for (int task = c; task < ntask; task += G) topk_task((LAS int*)lds, task >> 4, task & 15, AFF, TOK, POS); }
        GRID_BAR(); }
        LAUNDER();
        const int npm = last ? 8 : 9;
        REP(8) {
        { LAS int* tokl = (LAS int*)(lds + LDS_TOK);
          SchedMoe S{(const char*)H, (const char*)(ws + WS_WGU) + (size_t)l * NE * 2 * FF * D * 2, npm, 16, G, c, 0, (size_t)2 * FF * D * 2, D * 2, tokl};
          { pg8::Unit u; for (int i = 0; S.next(i, u); ++i) if (tid < 256) tokl[i * 256 + tid] = TOK[u.aux * EROWS + (u.pm < 8 ? u.pm * 256 + tid : 2048 + (tid & 127))]; }
          __syncthreads();
          EpiGU E{ACT}; pg8::gemm_phase<true>(lds, D, D * 2, D * 2, S, E); }
        GRID_BAR(); }
        LAUNDER();
        REP(9) {
        { SchedMoe S{(const char*)ACT, (const char*)(ws + WS_WD) + (size_t)l * NE * D * FF * 2, npm, 8, G, c, (size_t)EROWS * FF * 2, (size_t)D * FF * 2, FF * 2, nullptr};
          EpiDown E{Y}; pg8::gemm_phase<false>(lds, FF, FF * 2, FF * 2, S, E); }
        GRID_BAR(); }
        LAUNDER();
        REP(15) for (int t0 = gw; t0 < rows; t0 += 2 * NGW) { const int t1 = (t0 + NGW < rows) ? t0 + NGW : t0; const bool two = (t1 != t0);
            bf16* Xw = X; bf16* Hw = H; float* Ow = (float*)IN(22); if (PROBE_DUP == 15 && rep_ == 0) { Xw = (bf16*)(ws + WS_ACT); Hw = (bf16*)(ws + WS_PC); Ow = (float*)(ws + WS_ACT); }
            f32x4 v0[8], v1[8], s0[8], s1[8]; row_load_bf(X + (size_t)t0 * D, lane, v0); row_load_bf(X + (size_t)t1 * D, lane, v1);
            const int pl0 = (lane < 16) ? POS[(size_t)t0 * 16 + lane] : -1, pl1 = (lane < 16) ? POS[(size_t)t1 * 16 + lane] : -1;
            const float al0 = (lane < 16) ? AFF[(size_t)t0 * 16 + lane] : 0.f, al1 = (lane < 16) ? AFF[(size_t)t1 * 16 + lane] : 0.f;
#pragma unroll
            for (int j = 0; j < 8; ++j) { s0[j] = (f32x4){0.f, 0.f, 0.f, 0.f}; s1[j] = (f32x4){0.f, 0.f, 0.f, 0.f}; }
            unsigned long long sel0 = __ballot(pl0 >= 0), sel1 = __ballot(pl1 >= 0);
            while (sel0 | sel1) {
                const bool h0 = sel0 != 0ull, h1 = sel1 != 0ull; const int e0 = h0 ? __builtin_ctzll(sel0) : 0, e1 = h1 ? __builtin_ctzll(sel1) : 0; sel0 &= sel0 - 1; sel1 &= sel1 - 1;
                const int p0 = h0 ? __builtin_amdgcn_readlane(pl0, e0) : 0, p1 = h1 ? __builtin_amdgcn_readlane(pl1, e1) : 0;
                const float a0 = h0 ? __builtin_bit_cast(float, __builtin_amdgcn_readlane(__builtin_bit_cast(int, al0), e0)) : 0.f, a1 = h1 ? __builtin_bit_cast(float, __builtin_amdgcn_readlane(__builtin_bit_cast(int, al1), e1)) : 0.f;
                const bf16* y0 = Y + (size_t)p0 * D + 4 * lane; const bf16* y1 = Y + (size_t)p1 * D + 4 * lane; u32x2 w0[8], w1[8];
#pragma unroll
                for (int j = 0; j < 8; ++j) { w0[j] = *(const u32x2*)(y0 + 256 * j); w1[j] = *(const u32x2*)(y1 + 256 * j); }
#pragma unroll
                for (int j = 0; j < 8; ++j) { s0[j] += (f32x4){bf_lo(w0[j].x), bf_hi(w0[j].x), bf_lo(w0[j].y), bf_hi(w0[j].y)} * a0; s1[j] += (f32x4){bf_lo(w1[j].x), bf_hi(w1[j].x), bf_lo(w1[j].y), bf_hi(w1[j].y)} * a1; } }
            const float* g20 = MODL + mod_row(t0) * 6 * D + 5 * D; const float* g21 = MODL + mod_row(t1) * 6 * D + 5 * D;
#pragma unroll
            for (int j = 0; j < 8; ++j) { v0[j] += *(const f32x4*)(g20 + 4 * lane + 256 * j) * s0[j]; v1[j] += *(const f32x4*)(g21 + 4 * lane + 256 * j) * s1[j]; }
            if (!last) {
#pragma unroll
                for (int j = 0; j < 8; ++j) { *(u32x2*)(Xw + (size_t)t0 * D + 4 * lane + 256 * j) = pack4(v0[j]); if (two) *(u32x2*)(Xw + (size_t)t1 * D + 4 * lane + 256 * j) = pack4(v1[j]); }
                const float* m0 = MOD + (size_t)(l + 1) * 5 * 6 * D + mod_row(t0) * 6 * D; const float* m1 = MOD + (size_t)(l + 1) * 5 * 6 * D + mod_row(t1) * 6 * D;
                row_norm_mod(v0, lane, IN(I_N1G) + (l + 1) * D, m0, m0 + D, Hw + (size_t)t0 * D); row_norm_mod(v1, lane, IN(I_N1G) + (l + 1) * D, m1, m1 + D, Hw + (size_t)t1 * D);
            } else { const float r0 = rsqrtf(row_ssq(v0) * (1.0f / D) + EPS), r1 = rsqrtf(row_ssq(v1) * (1.0f / D) + EPS); float* od = Ow;
#pragma unroll
                for (int j = 0; j < 8; ++j) { const f32x4 fg = *(const f32x4*)(IN(I_FNG) + 4 * lane + 256 * j); *(f32x4*)(od + (size_t)t0 * D + 4 * lane + 256 * j) = v0[j] * r0 * fg; if (two) *(f32x4*)(od + (size_t)t1 * D + 4 * lane + 256 * j) = v1[j] * r1 * fg; } }
        }
        if (!last) GRID_BAR();
    }
}

extern "C" void kernel_launch(void* const* d_in, const int* in_sizes, int n_in, void* d_out, int out_size, void* d_ws, size_t ws_size, hipStream_t stream) {
    static int grid = 0;
    if (grid == 0) {
        if (n_in != 22 || out_size != TL * D || ws_size < WS_END) { fprintf(stderr, "kernel_launch: unexpected problem (n_in %d, out %d, ws %zu < %zu)\n", n_in, out_size, ws_size, (size_t)WS_END); grid = -1; return; }
        int dev = 0, cus = 0, per_cu = 0;
        if (hipGetDevice(&dev) != hipSuccess || hipDeviceGetAttribute(&cus, hipDeviceAttributeMultiprocessorCount, dev) != hipSuccess) { grid = -1; return; }
        if (hipFuncSetAttribute((const void*)mega_fwd, hipFuncAttributeMaxDynamicSharedMemorySize, LDS_BYTES) != hipSuccess) { fprintf(stderr, "kernel_launch: hipFuncSetAttribute failed\n"); grid = -1; return; }
        if (hipOccupancyMaxActiveBlocksPerMultiprocessor(&per_cu, (const void*)mega_fwd, NTHR, LDS_BYTES) != hipSuccess || per_cu < 1) { fprintf(stderr, "kernel_launch: occupancy query reports %d\n", per_cu); (void)hipGetLastError(); grid = -1; return; }
        if (cus < 144) { fprintf(stderr, "kernel_launch: %d CUs: this kernel needs at least 144\n", cus); grid = -1; return; }
        grid = cus;
    }
    if (grid < 0) return;
    if (hipMemsetAsync((char*)d_ws + WS_CTL + (size_t)CW_BAR * 4, 0, (size_t)XCD_BAR_WORDS * 4, stream) != hipSuccess) return;
    Args a{};
    for (int i = 0; i < 22; ++i) a.in[i] = (const float*)d_in[i];
    a.out = (float*)d_out; a.ws = (unsigned char*)d_ws;
    hipLaunchKernelGGL(mega_fwd, dim3(grid), dim3(NTHR), LDS_BYTES, stream, a);
}
```

```cpp
#include <hip/hip_runtime.h>
#include <cstdio>
#include <cstdint>

#define GAS __attribute__((address_space(1)))
#define LAS __attribute__((address_space(3)))
typedef unsigned short bf16;
typedef unsigned u32x4 __attribute__((ext_vector_type(4)));
typedef unsigned u32x2 __attribute__((ext_vector_type(2)));
typedef float f32x4 __attribute__((ext_vector_type(4)));
typedef float f32x2 __attribute__((ext_vector_type(2)));
typedef float f32x16 __attribute__((ext_vector_type(16)));
typedef short bf16x8 __attribute__((ext_vector_type(8)));
typedef short s16x4 __attribute__((ext_vector_type(4)));
typedef __bf16 bf16x2_t __attribute__((ext_vector_type(2)));

constexpr int D = 2048, NB = 4, SEQ = 4096, CTXL = 256;
constexpr int TL = NB * SEQ, TC = NB * CTXL, T = TL + TC;
constexpr int INC = 3616, NE = 16, FF = 2048, CAPL = 512, CAPC = 32;
constexpr int KVR = SEQ + CTXL;
constexpr int EROWS = 2304;
constexpr float EPS = 1e-6f;
constexpr float LOG2E = 1.4426950408889634f;
constexpr float QSC_S = 0.125f * LOG2E;
constexpr float QSC_M = 0.10206207261596575f * LOG2E;
constexpr int NWAVES = 8, NTHR = 512;

__device__ __forceinline__ unsigned cvtpk(float lo, float hi) { f32x2 v = {lo, hi}; bf16x2_t b = __builtin_convertvector(v, bf16x2_t); return __builtin_bit_cast(unsigned, b); }
__device__ __forceinline__ float bf_lo(unsigned w) { return __uint_as_float(w << 16); }
__device__ __forceinline__ float bf_hi(unsigned w) { return __uint_as_float(w & 0xffff0000u); }
__device__ __forceinline__ float wave_sum(float v) {
#define WS_DPP(ctrl) v += __builtin_bit_cast(float, __builtin_amdgcn_update_dpp(0, __builtin_bit_cast(int, v), (ctrl), 0xF, 0xF, true))
    WS_DPP(0xB1); WS_DPP(0x4E); WS_DPP(0x141); WS_DPP(0x140);
#undef WS_DPP
    v += __shfl_xor(v, 16); v += __shfl_xor(v, 32);
    return v;
}
__device__ __forceinline__ float silu_f(float v) { return v / (1.0f + __expf(-v)); }
__device__ __forceinline__ int mod_row(int t) { return t < TL ? (t >> 12) : 4; }
__device__ __forceinline__ int kv_row(int t) { return t < TL ? (t >> 12) * KVR + (t & (SEQ - 1)) : ((t - TL) >> 8) * KVR + SEQ + ((t - TL) & (CTXL - 1)); }

#define XB_TMO      128
#define XB_XCNT(j)  (256  + 64 * (j))
#define XB_XSUB(j)  (1280 + 64 * (j))
#define XB_XGEN(j)  (2304 + 64 * (j))
#define XB_TOP      3328
#define XB_TOPGEN   3392
#define XCD_BAR_WORDS 3456
#define XB_SPIN_CAP (1u << 18)
__device__ __forceinline__ unsigned xb_ld(unsigned* p)              { return __hip_atomic_load(p, __ATOMIC_RELAXED, __HIP_MEMORY_SCOPE_AGENT); }
__device__ __forceinline__ unsigned xb_add(unsigned* p, unsigned v) { return __hip_atomic_fetch_add(p, v, __ATOMIC_RELAXED, __HIP_MEMORY_SCOPE_AGENT); }
__device__ __forceinline__ unsigned xb_xcc_id() { return (unsigned)__builtin_amdgcn_s_getreg((3 << 11) | 20) & 0xFu; }
#define XB_SPIN(cond, bar) do { unsigned _sp = 0; while (cond) { __builtin_amdgcn_s_sleep(1); \
    if ((++_sp & 255u) == 0u) { if (xb_ld(&(bar)[XB_TMO])) break; if (_sp > XB_SPIN_CAP) { atomicAdd(&(bar)[XB_TMO], 1u); break; } } } } while (0)
struct XcdBarrier { unsigned* bar; unsigned x; volatile LAS unsigned* st; };
__device__ __forceinline__ XcdBarrier xcd_barrier_post(unsigned* bar, volatile LAS unsigned* st) {
    XcdBarrier b; b.bar = bar; b.x = xb_xcc_id(); b.st = st;
    if (threadIdx.x == 0) (void)xb_add(&bar[XB_XCNT(b.x)], 1u);
    return b;
}
__device__ __forceinline__ void xcd_barrier_complete(unsigned* bar, unsigned x, unsigned& nloc, unsigned& nx) {
    const unsigned G = gridDim.x * gridDim.y * gridDim.z;
    unsigned sum, cnt, mine, sp = 0u;
    for (;;) {
        sum = 0u; cnt = 0u; mine = 0u;
#pragma unroll
        for (unsigned j = 0; j < 16; ++j) { const unsigned c = xb_ld(&bar[XB_XCNT(j)]); sum += c; cnt += (c > 0u) ? 1u : 0u; mine = (j == x) ? c : mine; }
        if (sum == G) break;
        __builtin_amdgcn_s_sleep(1);
        if ((++sp & 255u) == 0u) { if (xb_ld(&bar[XB_TMO])) break; if (sp > XB_SPIN_CAP) { atomicAdd(&bar[XB_TMO], 1u); break; } }
    }
    nloc = mine > 0u ? mine : 1u; nx = cnt > 0u ? cnt : 1u;
}
__device__ __forceinline__ void xcd_barrier(const XcdBarrier& b) {
    asm volatile("s_waitcnt vmcnt(0)" ::: "memory");
    __syncthreads();
    if (threadIdx.x == 0) {
        unsigned* bar = b.bar;
        __builtin_amdgcn_s_waitcnt(0);
        unsigned nloc = b.st[0], nx = b.st[1];
        if (nloc == 0u) { xcd_barrier_complete(bar, b.x, nloc, nx); b.st[0] = nloc; b.st[1] = nx; }
        const unsigned old = xb_add(&bar[XB_XSUB(b.x)], 1u);
        const unsigned gen = old / nloc;
        if (old + 1u == (gen + 1u) * nloc) {
            __builtin_amdgcn_fence(__ATOMIC_RELEASE, "agent");
            asm volatile("s_waitcnt vmcnt(0)" ::: "memory");
            const unsigned og = xb_add(&bar[XB_TOP], 1u);
            const unsigned tg = og / nx;
            if (og + 1u == (tg + 1u) * nx) xb_add(&bar[XB_TOPGEN], 1u);
            else XB_SPIN(xb_ld(&bar[XB_TOPGEN]) == tg, bar);
            __builtin_amdgcn_fence(__ATOMIC_ACQUIRE, "agent");
            xb_add(&bar[XB_XGEN(b.x)], 1u);
            asm volatile("s_waitcnt vmcnt(0)" ::: "memory");
        } else {
            XB_SPIN(xb_ld(&bar[XB_XGEN(b.x)]) == gen, bar);
            __builtin_amdgcn_fence(__ATOMIC_ACQUIRE, "agent");
            asm volatile("s_waitcnt vmcnt(0)" ::: "memory");
        }
    }
    __syncthreads();
}

namespace pg8 {
constexpr int BM = 256, BK = 64, HALF = 128, HTB = HALF * BK * 2, STAGE_BYTES = 8 * HTB;
__device__ __forceinline__ int lds_byte(int r, int c) { const int st = (r >> 4) * 2 + (c >> 5), rr = r & 15, cc = c & 31, ob = rr * 64 + cc * 2; return st * 1024 + (ob ^ (((ob >> 9) & 1) << 5)); }
__device__ __forceinline__ void stage_rc(int b, int& R, int& C) { const int st = b / 1024, sb = b % 1024, swz = sb ^ (((sb >> 9) & 1) << 5); R = (st >> 1) * 16 + swz / 64; C = (st & 1) * 32 + (swz % 64) / 2; }
__device__ __forceinline__ int perm32(int rho) { const int n = rho >> 4, i = rho & 15; return 8 * (i >> 2) + 4 * n + (i & 3); }

struct Unit { const char* a; const char* b; int pm, pn, kind, aux; };

template <bool GATHER, class Epi, class Sched>
__device__ __forceinline__ void gemm_phase(LAS unsigned char* lds, const int K, const unsigned lda, const unsigned ldb, const Sched& S, const Epi& E) {
    int tid_ = threadIdx.x; asm volatile("" : "+v"(tid_));
    const int tid = tid_, wid = __builtin_amdgcn_readfirstlane(tid >> 6), lane = tid & 63, wr = wid >> 2, wc = wid & 3, fr = lane & 15, fq = lane >> 4;
    const int nt = K / BK;
    int Rr[2], Cc[2]; unsigned voffB[2];
#pragma unroll
    for (int i = 0; i < 2; ++i) { stage_rc(tid * 16 + i * 8192, Rr[i], Cc[i]); const int Rb = (Rr[i] & ~31) + perm32(Rr[i] & 31); voffB[i] = (unsigned)Rb * ldb + (unsigned)Cc[i] * 2u; }
    const size_t kstep = (size_t)(BK * 2);
    const size_t hstepB = (size_t)HALF * ldb;
    const unsigned ldsw = (unsigned)wid * 1024u;
    const int aoff = lds_byte(wr * 64 + fr, fq * 8), boff = lds_byte(wc * 32 + fr, fq * 8);
#define PG8_SA(b, h) (((b) * 2 + (h)) * HTB)
#define PG8_SB(b, h) ((4 + (b) * 2 + (h)) * HTB)
#define PG8_STAGE(bufoff, gbase, voff) do { _Pragma("unroll") for (int _i = 0; _i < 2; ++_i) \
        __builtin_amdgcn_global_load_lds((const unsigned*)((const char*)(gbase) + (voff)[_i]), (LAS unsigned*)(lds + (bufoff) + ldsw + _i * 8192), 16, 0, 0); } while (0)
#define PG8_LDA(dst, b, h) do { _Pragma("unroll") for (int m = 0; m < 4; ++m) _Pragma("unroll") for (int k = 0; k < 2; ++k) dst[m][k] = *(const LAS bf16x8*)(lds + PG8_SA(b, h) + aoff + m * 2048 + k * 1024); } while (0)
#define PG8_LDB(dst, b, h) do { _Pragma("unroll") for (int n = 0; n < 2; ++n) _Pragma("unroll") for (int k = 0; k < 2; ++k) dst[n][k] = *(const LAS bf16x8*)(lds + PG8_SB(b, h) + boff + n * 2048 + k * 1024); } while (0)
#define PG8_MMA(ai, bj, At, Bt) do { __builtin_amdgcn_s_setprio(1); _Pragma("unroll") for (int m = 0; m < 4; ++m) _Pragma("unroll") for (int n = 0; n < 2; ++n) _Pragma("unroll") for (int k = 0; k < 2; ++k) \
        acc[ai][bj][m][n] = __builtin_amdgcn_mfma_f32_16x16x32_bf16(Bt[n][k], At[m][k], acc[ai][bj][m][n], 0, 0, 0); __builtin_amdgcn_s_setprio(0); } while (0)
#define PG8_WAIT_V(n) asm volatile("s_waitcnt vmcnt(" #n ")" ::: "memory")
#define PG8_WAIT_L(n) asm volatile("s_waitcnt lgkmcnt(" #n ")" ::: "memory")
#define PG8_BAR __builtin_amdgcn_s_barrier()
#define PG8_SCHED __builtin_amdgcn_sched_barrier(0)
#define PG8_OFFS(dst, ui_) do { _Pragma("unroll") for (int _h = 0; _h < 2; ++_h) _Pragma("unroll") for (int _i = 0; _i < 2; ++_i) \
        dst[_h][_i] = (GATHER ? S.rowoff((ui_), _h * HALF + Rr[_i]) : (unsigned)(_h * HALF + Rr[_i]) * lda) + (unsigned)Cc[_i] * 2u; } while (0)
    Unit cur, nxt; int ui = 0;
    if (!S.next(0, cur)) return;
    f32x4 acc[2][2][4][2];
#pragma unroll
    for (int a = 0; a < 2; ++a)
#pragma unroll
        for (int b = 0; b < 2; ++b)
#pragma unroll
            for (int m = 0; m < 4; ++m)
#pragma unroll
                for (int n = 0; n < 2; ++n) acc[a][b][m][n] = (f32x4){0.f, 0.f, 0.f, 0.f};
    bf16x8 At[4][2], B0[2][2], B1[2][2];
    unsigned oAc[2][2], oAn[2][2];
    PG8_OFFS(oAc, 0);
    const char* cA = cur.a; const char* cB = cur.b;
    PG8_STAGE(PG8_SB(0, 0), cB, voffB); PG8_STAGE(PG8_SB(0, 1), cB + hstepB, voffB); PG8_STAGE(PG8_SA(0, 0), cA, oAc[0]); PG8_STAGE(PG8_SA(0, 1), cA, oAc[1]);
    if (wr == 1) PG8_BAR;
    PG8_WAIT_V(2); PG8_BAR;
    PG8_STAGE(PG8_SB(1, 0), cB + kstep, voffB); PG8_STAGE(PG8_SA(1, 0), cA + kstep, oAc[0]); PG8_STAGE(PG8_SB(1, 1), cB + hstepB + kstep, voffB);
    PG8_WAIT_V(6); PG8_BAR;
    for (;;) {
        const bool has_next = S.next(ui + 1, nxt);
        const char* nA = has_next ? nxt.a : cA; const char* nB = has_next ? nxt.b : cB;
        if constexpr (GATHER) { if (has_next) { PG8_OFFS(oAn, ui + 1); } else {
#pragma unroll
            for (int h = 0; h < 2; ++h)
#pragma unroll
                for (int i = 0; i < 2; ++i) oAn[h][i] = oAc[h][i]; } }
        for (int t = 0; t < nt; t += 2) {
            const bool last = (t == nt - 2);
            const char* a1 = cA + (size_t)(t + 1) * kstep;
            const char* a2 = last ? nA : cA + (size_t)(t + 2) * kstep; const char* b2 = last ? nB : cB + (size_t)(t + 2) * kstep;
            const char* a3 = a2 + kstep; const char* b3 = b2 + kstep;
            unsigned oAx[2][2];
#pragma unroll
            for (int h = 0; h < 2; ++h)
#pragma unroll
                for (int i = 0; i < 2; ++i) { if constexpr (GATHER) oAx[h][i] = last ? oAn[h][i] : oAc[h][i]; else oAx[h][i] = oAc[h][i]; }
            PG8_LDB(B0, 0, 0); PG8_LDB(B1, 0, 1); PG8_SCHED; PG8_LDA(At, 0, 0); PG8_STAGE(PG8_SA(1, 1), a1, oAc[1]);
            PG8_WAIT_V(8); PG8_WAIT_L(0); PG8_BAR; PG8_MMA(0, 0, At, B0); PG8_MMA(0, 1, At, B1); PG8_BAR; PG8_SCHED;
            PG8_LDA(At, 0, 1); PG8_STAGE(PG8_SB(0, 0), b2, voffB); PG8_STAGE(PG8_SB(0, 1), b2 + hstepB, voffB); PG8_STAGE(PG8_SA(0, 0), a2, oAx[0]);
            PG8_WAIT_V(8); PG8_WAIT_L(0); PG8_BAR; PG8_MMA(1, 0, At, B0); PG8_MMA(1, 1, At, B1); PG8_BAR; PG8_SCHED;
            PG8_LDB(B0, 1, 0); PG8_LDB(B1, 1, 1); PG8_SCHED; PG8_LDA(At, 1, 0); PG8_STAGE(PG8_SA(0, 1), a2, oAx[1]);
            PG8_WAIT_V(8); PG8_WAIT_L(0); PG8_BAR; PG8_MMA(0, 0, At, B0); PG8_MMA(0, 1, At, B1); PG8_BAR; PG8_SCHED;
            PG8_LDA(At, 1, 1); PG8_STAGE(PG8_SB(1, 0), b3, voffB); PG8_STAGE(PG8_SB(1, 1), b3 + hstepB, voffB); PG8_STAGE(PG8_SA(1, 0), a3, oAx[0]);
            PG8_WAIT_V(8); PG8_WAIT_L(0); PG8_BAR; PG8_MMA(1, 0, At, B0); PG8_MMA(1, 1, At, B1); PG8_BAR; PG8_SCHED;
        }
        if (wr == 0) PG8_BAR;
        E(acc, cur, wr, wc, fr, fq);
        if (!has_next) break;
#pragma unroll
        for (int a = 0; a < 2; ++a)
#pragma unroll
            for (int b = 0; b < 2; ++b)
#pragma unroll
                for (int m = 0; m < 4; ++m)
#pragma unroll
                    for (int n = 0; n < 2; ++n) acc[a][b][m][n] = (f32x4){0.f, 0.f, 0.f, 0.f};
        cur = nxt; cA = nA; cB = nB; ++ui;
        if constexpr (GATHER) {
#pragma unroll
        for (int h = 0; h < 2; ++h)
#pragma unroll
            for (int i = 0; i < 2; ++i) oAc[h][i] = oAn[h][i]; }
        if (wr == 1) PG8_BAR;
    }
    PG8_WAIT_V(0);
    PG8_BAR;
#undef PG8_SA
#undef PG8_SB
#undef PG8_STAGE
#undef PG8_LDA
#undef PG8_LDB
#undef PG8_MMA
#undef PG8_WAIT_V
#undef PG8_WAIT_L
#undef PG8_BAR
#undef PG8_SCHED
#undef PG8_OFFS
}
}
constexpr size_t al256(size_t x) { return (x + 255) & ~(size_t)255; }
constexpr size_t WS_CTL = 0, CTL_ZERO_BYTES = 1u << 20;
constexpr int CW_BAR = 4096;
constexpr size_t CTL_MOD = 65536;
constexpr int NIN_MAIN = 3328, NIN_F = 1024, NUP = 1792, KUP = 768;
constexpr size_t WS_WIN  = CTL_ZERO_BYTES;
constexpr size_t WS_WUP  = WS_WIN  + al256((size_t)2 * (NIN_MAIN + NIN_F) * D * 2);
constexpr size_t WS_WO   = WS_WUP  + al256((size_t)2 * NUP * KUP * 2);
constexpr size_t WS_WGU  = WS_WO   + al256((size_t)2 * D * D * 2);
constexpr size_t WS_WD   = WS_WGU  + al256((size_t)2 * NE * 2 * FF * D * 2);
constexpr size_t WS_DN   = WS_WD   + al256((size_t)2 * NE * D * FF * 2);
constexpr size_t WS_DL   = WS_DN   + al256((size_t)SEQ * 2 * SEQ * 2);
constexpr size_t WS_ROPS = WS_DL   + al256((size_t)CTXL * 2 * CTXL * 2);
constexpr size_t WS_ROPM = WS_ROPS + al256((size_t)SEQ * 32 * 8);
constexpr size_t WS_X    = WS_ROPM + al256((size_t)SEQ * 16 * 8);
constexpr size_t WS_H    = WS_X    + al256((size_t)T * D * 4);
constexpr size_t WS_PC   = WS_H    + al256((size_t)T * D * 2);
constexpr size_t WS_SQ   = WS_PC   + al256((size_t)T * 1536 * 2);
constexpr size_t WS_KS   = WS_SQ   + al256((size_t)T * 512 * 2);
constexpr size_t WS_VS   = WS_KS   + al256((size_t)NB * KVR * 128 * 2);
constexpr size_t WS_MCQ  = WS_VS   + al256((size_t)NB * KVR * 128 * 2);
constexpr size_t WS_QM   = WS_MCQ  + al256((size_t)T * 768 * 2);
constexpr size_t WS_KM   = WS_QM   + al256((size_t)T * 768 * 2);
constexpr size_t WS_VM   = WS_KM   + al256((size_t)NB * KVR * 768 * 2);
constexpr size_t WS_KPE  = WS_KM + (size_t)NB * KVR * 512 * 2;
constexpr size_t WS_GT   = WS_VM   + al256((size_t)NB * KVR * 512 * 2);
constexpr size_t WS_GTC  = WS_GT   + al256((size_t)NB * 512 * 8192 * 2);
constexpr size_t WS_YMIX = WS_GTC  + al256((size_t)NB * 512 * 512 * 2);
constexpr size_t WS_SSQ  = WS_YMIX + al256((size_t)T * D * 2);
constexpr size_t WS_MODP = WS_SSQ  + al256((size_t)T * 12 * 4);
constexpr int ADA_KC = 8;
constexpr size_t WS_AFF  = WS_MODP + al256((size_t)ADA_KC * 2 * 5 * 6 * D * 4);
constexpr size_t WS_POS  = WS_AFF  + al256((size_t)T * 16 * 4);
constexpr size_t WS_TOK  = WS_POS  + al256((size_t)T * 16 * 4);
constexpr size_t WS_ACT  = WS_TOK  + al256((size_t)NE * EROWS * 4);
constexpr size_t WS_Y    = WS_ACT  + al256((size_t)NE * EROWS * FF * 2);
constexpr size_t WS_GTF  = WS_Y    + al256((size_t)NE * EROWS * D * 2);
constexpr size_t WS_END  = WS_GTF  + al256((size_t)NB * 512 * SEQ * 2);

constexpr int RING_BYTES = 131072;
constexpr int LDS_TOK = RING_BYTES;
constexpr int LDS_MISC = LDS_TOK + 16 * 1024;
constexpr int LDS_ARGS = LDS_MISC + 256;
constexpr int LDS_BYTES = LDS_ARGS + 256;
__device__ __forceinline__ const float* lds_arg(LAS unsigned char* lds, int i) { const u32x2 v = *(const LAS u32x2*)(lds + LDS_ARGS + 8 * i); const unsigned lo = __builtin_amdgcn_readfirstlane(v.x), hi = __builtin_amdgcn_readfirstlane(v.y); return (const float*)(const GAS float*)(((unsigned long long)hi << 32) | lo); }
#define IN(i) lds_arg(lds, (i))

#define EPI_ARGS const f32x4 (&acc)[2][2][4][2], const pg8::Unit& u, int wr, int wc, int fr, int fq
#define EPI_OPAQUE() asm volatile("" : "+v"(fr), "+v"(fq))
__device__ __forceinline__ u32x4 pack8(const f32x4 a, const f32x4 b) { u32x4 w; w.x = cvtpk(a[0], a[1]); w.y = cvtpk(a[2], a[3]); w.z = cvtpk(b[0], b[1]); w.w = cvtpk(b[2], b[3]); return w; }
__device__ __forceinline__ u32x2 pack4(const f32x4 a) { u32x2 w; w.x = cvtpk(a[0], a[1]); w.y = cvtpk(a[2], a[3]); return w; }
__device__ __forceinline__ void rope4(f32x4& x1, f32x4& x2, const f32x2* cs) {
#pragma unroll
    for (int j = 0; j < 4; ++j) { const f32x2 c = cs[j]; const float a = x1[j], b = x2[j]; x1[j] = a * c.x - b * c.y; x2[j] = b * c.x + a * c.y; }
}

struct EpiInproj {
    unsigned char* ws;
    __device__ __forceinline__ void operator()(EPI_ARGS) const { EPI_OPAQUE();
        bf16* const PC = (bf16*)(ws + WS_PC); bf16* const SQ = (bf16*)(ws + WS_SQ); bf16* const KS = (bf16*)(ws + WS_KS); bf16* const VS = (bf16*)(ws + WS_VS); bf16* const MCQ = (bf16*)(ws + WS_MCQ);
        bf16* const KM = (bf16*)(ws + WS_KM); bf16* const GT = (bf16*)(ws + WS_GT); bf16* const GTC = (bf16*)(ws + WS_GTC); float* const SSQ = (float*)(ws + WS_SSQ);
        const f32x2* const ROPS = (const f32x2*)(ws + WS_ROPS); const f32x2* const ROPM = (const f32x2*)(ws + WS_ROPM);
        if (u.kind == 1) {
#pragma unroll
            for (int ai = 0; ai < 2; ++ai)
#pragma unroll
                for (int m = 0; m < 4; ++m) {
                    const int r = 256 * u.pm + 128 * ai + 64 * wr + 16 * m + fr, g = r >> 6, s = r & 63; const bool is_sin = s > 32; const int cq = is_sin ? s - 32 : s, part = is_sin ? 1 : 0;
                    const bool mir = (cq & 31) != 0; const int j0 = g * 64 + cq, j1 = g * 64 + ((64 - cq) & 63); const unsigned flip = is_sin ? 0x80008000u : 0u;
#pragma unroll
                    for (int bj = 0; bj < 2; ++bj) { const int tok = 256 * u.pn + 128 * bj + 32 * wc + 8 * fq; bf16* d0; size_t rs, ps;
                        if (tok < TL) { d0 = GT + (size_t)(tok >> 12) * 512 * 8192 + (tok & 4095); rs = 8192; ps = 4096; }
                        else { const int tc = tok - TL; d0 = GTC + (size_t)(tc >> 8) * 512 * 512 + (tc & 255); rs = 512; ps = 256; }
                        const u32x4 v = pack8(acc[ai][bj][m][0], acc[ai][bj][m][1]);
                        *(u32x4*)(d0 + j0 * rs + part * ps) = v;
                        if (tok >= TL) {
                            if (mir) *(u32x4*)(d0 + j1 * rs + part * ps) = (u32x4){v.x ^ flip, v.y ^ flip, v.z ^ flip, v.w ^ flip};
                            else *(u32x4*)(d0 + j0 * rs + ps) = (u32x4){0u, 0u, 0u, 0u}; } } }
            return;
        }
        const int pn = u.pn;
#pragma unroll
        for (int ai = 0; ai < 2; ++ai)
#pragma unroll
            for (int m = 0; m < 4; ++m) {
                int t = 256 * u.pm + 128 * ai + 64 * wr + 16 * m + fr; asm volatile("" : "+v"(t)); const bool lat = t < TL; const int npos = t & (SEQ - 1);
                if (pn < 6) {
#pragma unroll
                    for (int bj = 0; bj < 2; ++bj) *(u32x4*)(PC + (size_t)t * 1536 + 256 * pn + 128 * bj + 32 * wc + 8 * fq) = pack8(acc[ai][bj][m][0], acc[ai][bj][m][1]);
                } else if (pn < 8) {
#pragma unroll
                    for (int bj = 0; bj < 2; ++bj) { const int hc = 256 * (pn - 6) + 128 * bj + 32 * wc + 8 * fq, head = hc >> 6, a = (hc & 63) >> 3;
                        f32x4 x1 = acc[ai][bj][m][0], x2 = acc[ai][bj][m][1];
                        if (lat) rope4(x1, x2, ROPS + npos * 32 + 4 * a);
                        x1 *= QSC_S; x2 *= QSC_S;
                        bf16* o = SQ + (size_t)t * 512 + head * 64 + 4 * a; *(u32x2*)o = pack4(x1); *(u32x2*)(o + 32) = pack4(x2); }
                } else if (pn == 8) {
                    const int kr = kv_row(t);
                    { const int hc = 32 * wc + 8 * fq, head = hc >> 6, a = (hc & 63) >> 3; f32x4 x1 = acc[ai][0][m][0], x2 = acc[ai][0][m][1];
                      if (lat) rope4(x1, x2, ROPS + npos * 32 + 4 * a);
                      bf16* o = KS + (size_t)kr * 128 + head * 64 + 4 * a; *(u32x2*)o = pack4(x1); *(u32x2*)(o + 32) = pack4(x2); }
                    *(u32x4*)(VS + (size_t)kr * 128 + 32 * wc + 8 * fq) = pack8(acc[ai][1][m][0], acc[ai][1][m][1]);
                } else if (pn < 12) {
                    const int cb = pn < 11 ? 256 * (pn - 9) : 512; float s = 0.f;
#pragma unroll
                    for (int bj = 0; bj < 2; ++bj) { const f32x4 v0 = acc[ai][bj][m][0], v1 = acc[ai][bj][m][1];
                        *(u32x4*)(MCQ + (size_t)t * 768 + cb + 128 * bj + 32 * wc + 8 * fq) = pack8(v0, v1);
                        s += (v0[0] * v0[0] + v0[1] * v0[1]) + (v0[2] * v0[2] + v0[3] * v0[3]) + (v1[0] * v1[0] + v1[1] * v1[1]) + (v1[2] * v1[2] + v1[3] * v1[3]); }
                    s += __shfl_xor(s, 16); s += __shfl_xor(s, 32);
                    if (fq == 0) SSQ[(size_t)t * 12 + (pn - 9) * 4 + wc] = s;
                } else {
                    if (wc == 0) { const int a = fq; f32x4 x1 = acc[ai][0][m][0], x2 = acc[ai][0][m][1];
                        if (lat) rope4(x1, x2, ROPM + npos * 16 + 4 * a);
                        bf16* o = (bf16*)(ws + WS_KPE) + (size_t)kv_row(t) * 32 + 4 * a; *(u32x2*)o = pack4(x1); *(u32x2*)(o + 16) = pack4(x2); }
                }
                asm volatile("" ::: "memory");
            }
    }
};

struct EpiUp {
    unsigned char* ws;
    __device__ __forceinline__ void operator()(EPI_ARGS) const { EPI_OPAQUE();
        bf16* const QM = (bf16*)(ws + WS_QM); bf16* const KM = (bf16*)(ws + WS_KM); bf16* const VM = (bf16*)(ws + WS_VM); const float* const SSQ = (const float*)(ws + WS_SSQ); const f32x2* const ROPM = (const f32x2*)(ws + WS_ROPM);
        const int pn = u.pn; const bool isq = (u.aux == 0);
#pragma unroll
        for (int ai = 0; ai < 2; ++ai)
#pragma unroll
            for (int m = 0; m < 4; ++m) {
                int t = 256 * u.pm + 128 * ai + 64 * wr + 16 * m + fr; asm volatile("" : "+v"(t)); const bool lat = t < TL; const int npos = t & (SEQ - 1);
                if (isq) {
                    const f32x4 sa = *(const f32x4*)(SSQ + (size_t)t * 12), sb = *(const f32x4*)(SSQ + (size_t)t * 12 + 4);
                    const float rs = rsqrtf((((sa[0] + sa[1]) + (sa[2] + sa[3])) + ((sb[0] + sb[1]) + (sb[2] + sb[3]))) * (1.0f / 512.0f) + EPS) * QSC_M;
#pragma unroll
                    for (int bj = 0; bj < 2; ++bj) { const int c0 = 256 * pn + 128 * bj + 32 * wc + 8 * fq, head = c0 / 96, w = c0 - head * 96;
                        f32x4 x1 = acc[ai][bj][m][0], x2 = acc[ai][bj][m][1];
                        if (w < 64) { x1 *= rs; x2 *= rs; *(u32x4*)(QM + (size_t)t * 768 + c0) = pack8(x1, x2); }
                        else { const int a = (w - 64) >> 3; if (lat) rope4(x1, x2, ROPM + npos * 16 + 4 * a); x1 *= rs; x2 *= rs;
                            bf16* o = QM + (size_t)t * 768 + head * 96 + 64 + 4 * a; *(u32x2*)o = pack4(x1); *(u32x2*)(o + 16) = pack4(x2); } }
                } else {
                    const f32x4 sc = *(const f32x4*)(SSQ + (size_t)t * 12 + 8);
                    const float rs = rsqrtf(((sc[0] + sc[1]) + (sc[2] + sc[3])) * (1.0f / 256.0f) + EPS); const int kr = kv_row(t);
#pragma unroll
                    for (int bj = 0; bj < 2; ++bj) { const int c0 = 256 * pn + 128 * bj + 32 * wc + 8 * fq, head = c0 >> 7, w = c0 & 127;
                        const f32x4 x1 = acc[ai][bj][m][0] * rs, x2 = acc[ai][bj][m][1] * rs;
                        if (w < 64) *(u32x4*)(KM + (size_t)kr * 512 + head * 64 + w) = pack8(x1, x2);
                        else *(u32x4*)(VM + (size_t)kr * 512 + head * 64 + (w - 64)) = pack8(x1, x2); } }
                asm volatile("" ::: "memory");
            }
    }
};

struct EpiFnet {
    bf16* YMIX;
    __device__ __forceinline__ void operator()(EPI_ARGS) const { EPI_OPAQUE();
#pragma unroll
        for (int ai = 0; ai < 2; ++ai)
#pragma unroll
            for (int m = 0; m < 4; ++m) { const int n = 256 * u.pm + 128 * ai + 64 * wr + 16 * m + fr, t = u.aux * SEQ + n;
                bf16* const ym = YMIX + (size_t)(u.aux * SEQ + ((SEQ - n) & (SEQ - 1))) * D + 1024;
#pragma unroll
                for (int bj = 0; bj < 2; ++bj) { const int c0 = 256 * u.pn + 128 * bj + 32 * wc + 8 * fq; const u32x4 v = pack8(acc[ai][bj][m][0], acc[ai][bj][m][1]);
                    *(u32x4*)(YMIX + (size_t)t * D + 1024 + c0) = v;
                    if (n != 0) { const int gb = c0 & ~63, cq = c0 & 63, cb = gb + 56 - cq;
                        *(unsigned short*)(ym + gb + ((64 - cq) & 63)) = (unsigned short)(v.x & 0xffffu);
                        *(unsigned short*)(ym + cb + 1) = (unsigned short)(v.w >> 16);
                        *(unsigned*)(ym + cb + 2) = (v.w & 0xffffu) | (v.z & 0xffff0000u);
                        *(unsigned*)(ym + cb + 4) = (v.z & 0xffffu) | (v.y & 0xffff0000u);
                        *(unsigned*)(ym + cb + 6) = (v.y & 0xffffu) | (v.x & 0xffff0000u); } } }
    }
};

struct EpiOut {
    const float *xl, *xc; const bf16* xb; bf16* X; const float* MODL;
    __device__ __forceinline__ void operator()(EPI_ARGS) const { EPI_OPAQUE();
        const int tb = 256 * u.pm, cb = 256 * u.pn + 32 * wc + 8 * fq; const float* g1 = MODL + mod_row(tb) * 6 * D + 2 * D + cb;
        f32x4 gv[2][2];
#pragma unroll
        for (int bj = 0; bj < 2; ++bj)
#pragma unroll
            for (int n = 0; n < 2; ++n) gv[bj][n] = *(const f32x4*)(g1 + 128 * bj + 4 * n);
        if (xb) {
#pragma unroll
            for (int ai = 0; ai < 2; ++ai)
#pragma unroll
                for (int m2 = 0; m2 < 4; m2 += 2) { u32x4 w[2][2];
#pragma unroll
                    for (int mm = 0; mm < 2; ++mm) { const bf16* xin = xb + (size_t)(tb + 128 * ai + 64 * wr + 16 * (m2 + mm) + fr) * D + cb; w[mm][0] = *(const u32x4*)xin; w[mm][1] = *(const u32x4*)(xin + 128); }
#pragma unroll
                    for (int mm = 0; mm < 2; ++mm) { bf16* xo = X + (size_t)(tb + 128 * ai + 64 * wr + 16 * (m2 + mm) + fr) * D + cb;
#pragma unroll
                        for (int bj = 0; bj < 2; ++bj) { const u32x4 q = w[mm][bj]; const f32x4 x0 = {bf_lo(q.x), bf_hi(q.x), bf_lo(q.y), bf_hi(q.y)}, x1 = {bf_lo(q.z), bf_hi(q.z), bf_lo(q.w), bf_hi(q.w)};
                            *(u32x4*)(xo + 128 * bj) = pack8(x0 + gv[bj][0] * acc[ai][bj][m2 + mm][0], x1 + gv[bj][1] * acc[ai][bj][m2 + mm][1]); } }
                    asm volatile("" ::: "memory"); }
        } else {
#pragma unroll
            for (int ai = 0; ai < 2; ++ai)
#pragma unroll
                for (int m = 0; m < 4; ++m) { const int t = tb + 128 * ai + 64 * wr + 16 * m + fr; const float* xin = (t < TL ? xl + (size_t)t * D : xc + (size_t)(t - TL) * D) + cb; bf16* xo = X + (size_t)t * D + cb;
                    f32x4 xi[2][2];
#pragma unroll
                    for (int bj = 0; bj < 2; ++bj)
#pragma unroll
                        for (int n = 0; n < 2; ++n) xi[bj][n] = *(const f32x4*)(xin + 128 * bj + 4 * n);
#pragma unroll
                    for (int bj = 0; bj < 2; ++bj) *(u32x4*)(xo + 128 * bj) = pack8(xi[bj][0] + gv[bj][0] * acc[ai][bj][m][0], xi[bj][1] + gv[bj][1] * acc[ai][bj][m][1]);
                    asm volatile("" ::: "memory"); }
        }
    }
};

struct EpiGU {
    bf16* ACT;
    __device__ __forceinline__ void operator()(EPI_ARGS) const { EPI_OPAQUE();
#pragma unroll
        for (int ai = 0; ai < 2; ++ai) { if (u.pm == 8 && ai == 1) continue;
#pragma unroll
            for (int m = 0; m < 4; ++m) { const int row = u.aux * EROWS + 256 * u.pm + 128 * ai + 64 * wr + 16 * m + fr; f32x4 o[2];
#pragma unroll
                for (int n = 0; n < 2; ++n) { const f32x4 g = acc[ai][0][m][n], up = acc[ai][1][m][n];
#pragma unroll
                    for (int j = 0; j < 4; ++j) o[n][j] = g[j] * __builtin_amdgcn_rcpf(1.0f + __builtin_amdgcn_exp2f(-g[j] * LOG2E)) * up[j]; }
                *(u32x4*)(ACT + (size_t)row * FF + 128 * u.pn + 32 * wc + 8 * fq) = pack8(o[0], o[1]); } }
    }
};

struct EpiDown {
    bf16* Y;
    __device__ __forceinline__ void operator()(EPI_ARGS) const { EPI_OPAQUE();
#pragma unroll
        for (int ai = 0; ai < 2; ++ai) { if (u.pm == 8 && ai == 1) continue;
#pragma unroll
            for (int m = 0; m < 4; ++m) { const int row = u.aux * EROWS + 256 * u.pm + 128 * ai + 64 * wr + 16 * m + fr;
#pragma unroll
                for (int bj = 0; bj < 2; ++bj) *(u32x4*)(Y + (size_t)row * D + 256 * u.pn + 128 * bj + 32 * wc + 8 * fq) = pack8(acc[ai][bj][m][0], acc[ai][bj][m][1]); } }
    }
};

__device__ __forceinline__ void static_tile(int L, int nM, int nN, int& pm, int& pn) {
    const int nwg = nM * nN; int wgid = L; { const int q = nwg / 8, r = nwg % 8, xcd = wgid % 8, off = wgid / 8; wgid = (xcd < r ? xcd * (q + 1) : r * (q + 1) + (xcd - r) * q) + off; }
    const int nig = 8 * nN, gid = wgid / nig, fm = gid * 8, gsz = (nM - fm) < 8 ? (nM - fm) : 8;
    pm = fm + ((wgid % nig) % gsz); pn = (wgid % nig) / gsz;
}
struct SchedInproj {
    const char *H, *WM, *WF; int G, c;
    __device__ __forceinline__ bool next(int i, pg8::Unit& u) const {
        const int L = i * G + c; constexpr int NMAIN = 68 * 13;
        if (L < NMAIN) { static_tile(L, 68, 13, u.pm, u.pn); u.kind = 0; u.aux = 0; u.a = H + (size_t)u.pm * 256 * D * 2; u.b = WM + (size_t)u.pn * 256 * D * 2; return true; }
        const int k = L - NMAIN; if (k >= 2 * 68) return false;
        u.pm = k & 1; u.pn = k >> 1; u.kind = 1; u.aux = 0; u.a = WF + (size_t)u.pm * 256 * D * 2; u.b = H + (size_t)u.pn * 256 * D * 2; return true;
    }
    __device__ __forceinline__ unsigned rowoff(int, int) const { return 0u; }
};
struct SchedPlain {
    const char *A, *B; int nM, nN, G, c; unsigned lda, ldb; int aux;
    __device__ __forceinline__ bool next(int i, pg8::Unit& u) const {
        const int L = i * G + c; if (L >= nM * nN) return false;
        static_tile(L, nM, nN, u.pm, u.pn); u.kind = 0; u.aux = aux; u.a = A + (size_t)u.pm * 256 * lda; u.b = B + (size_t)u.pn * 256 * ldb; return true;
    }
    __device__ __forceinline__ unsigned rowoff(int, int) const { return 0u; }
};
struct SchedFnet {
    const char *DN, *GT; int c, G;
    __device__ __forceinline__ bool next(int i, pg8::Unit& u) const {
        int pm, bp;
        if (G == 256) { const int x = c & 7, li = c >> 3; if (i > 0 || li >= 8) return false; pm = (x & 3) * 2 + (li & 1); bp = (x >> 2) * 4 + (li >> 1); }
        else { const int id = c + i * G; if (id >= 64) return false; pm = id & 7; bp = id >> 3; }
        const int b = bp >> 1, pn = bp & 1;
        u.pm = pm; u.pn = pn; u.kind = 0; u.aux = b; u.a = DN + (size_t)pm * 256 * SEQ * 2; u.b = GT + (size_t)(b * 512 + pn * 256) * SEQ * 2; return true;
    }
    __device__ __forceinline__ unsigned rowoff(int, int) const { return 0u; }
};
struct SchedFnetC {
    const char *DL, *GTC; int c, G;
    __device__ __forceinline__ bool next(int i, pg8::Unit& u) const {
        int id; if (G == 256) { if (i > 0 || (c >> 3) != 8) return false; id = c & 7; } else { id = c + i * G; if (id >= 8) return false; }
        u.pm = 0; u.pn = id & 1; u.aux = id >> 1; u.kind = 0; u.a = DL; u.b = GTC + (size_t)(u.aux * 512 + u.pn * 256) * 512 * 2; return true;
    }
    __device__ __forceinline__ unsigned rowoff(int, int) const { return 0u; }
};
struct EpiFnetC {
    bf16* YMIX;
    __device__ __forceinline__ void operator()(EPI_ARGS) const { EPI_OPAQUE();
#pragma unroll
        for (int ai = 0; ai < 2; ++ai)
#pragma unroll
            for (int m = 0; m < 4; ++m) { const int t = TL + u.aux * CTXL + 128 * ai + 64 * wr + 16 * m + fr;
#pragma unroll
                for (int bj = 0; bj < 2; ++bj) *(u32x4*)(YMIX + (size_t)t * D + 1024 + 256 * u.pn + 128 * bj + 32 * wc + 8 * fq) = pack8(acc[ai][bj][m][0], acc[ai][bj][m][1]); }
    }
};
struct SchedMoe {
    const char *A, *B; int npm, nN, G, c; size_t sA, sB; unsigned ldb; const LAS int* tokl;
    __device__ __forceinline__ bool next(int i, pg8::Unit& u) const {
        const int per = npm * nN, nwg = NE * per; const int L = i * G + c; if (L >= nwg) return false;
        const int wgid = (L & 7) * (nwg >> 3) + (L >> 3);
        const int e = wgid / per, rem = wgid - e * per; u.pn = rem / npm; u.pm = rem - u.pn * npm; u.aux = e; u.kind = 0;
        u.a = A + (size_t)e * sA + (size_t)u.pm * 256 * (size_t)(D * 2) * (sA ? 1 : 0); u.b = B + (size_t)e * sB + (size_t)u.pn * 256 * ldb; return true;
    }
    __device__ __forceinline__ unsigned rowoff(int i, int r) const { return (unsigned)tokl[i * 256 + r] * (unsigned)(D * 2); }
};
namespace att {
constexpr int NSLOT = 4, LK = 0, KSLOT = 12288, LV = NSLOT * KSLOT, VSLOT = 8192, LWS = LV + NSLOT * VSLOT, LOST = LWS + NWAVES * 256, LDS_NEED = LOST + NWAVES * 4096;
static_assert(LDS_NEED <= RING_BYTES, "attention LDS");
typedef LAS const char* lds_cptr;
#define ATT_SBAR() __builtin_amdgcn_sched_barrier(0)
__device__ __forceinline__ int crow(int r, int hi) { return (r & 3) + 8 * (r >> 2) + 4 * hi; }
__device__ __forceinline__ void glds16(const void* gsrc, unsigned lds_dst) { unsigned keep;
    asm volatile("s_mov_b32 %0, m0\n\ts_mov_b32 m0, %2\n\ts_nop 0\n\tglobal_load_lds_dwordx4 %1, off\n\ts_mov_b32 m0, %0" : "=&s"(keep) : "v"(gsrc), "s"(lds_dst) : "memory"); }
__device__ __forceinline__ float vmax3(float a, float b, float c) { float d; asm("v_max3_f32 %0, %1, %2, %3" : "=v"(d) : "v"(a), "v"(b), "v"(c)); return d; }
__device__ __forceinline__ float rowmax(const f32x16& p0, const f32x16& p1) {
    float a = fmaxf(p0[0], p1[0]);
#pragma unroll
    for (int r = 1; r < 16; ++r) a = fmaxf(a, fmaxf(p0[r], p1[r]));
    auto rr = __builtin_amdgcn_permlane32_swap(__float_as_uint(a), __float_as_uint(a), false, false);
    return fmaxf(__uint_as_float(rr[0]), __uint_as_float(rr[1]));
}
__device__ __forceinline__ void pv(f32x16* o, int vb, bf16x8 pa0, bf16x8 pa1, bf16x8 pa2, bf16x8 pa3) {
    s16x4 lo[2][4], hi[2][4];
#pragma unroll
    for (int d0 = 0; d0 < 2; ++d0)
#pragma unroll
        for (int ks = 0; ks < 4; ++ks) {
            asm volatile("ds_read_b64_tr_b16 %0,%1 offset:%c2" : "=&v"(lo[d0][ks]) : "v"(vb), "i"(d0 * 4096 + ks * 1024) : "memory");
            asm volatile("ds_read_b64_tr_b16 %0,%1 offset:%c2" : "=&v"(hi[d0][ks]) : "v"(vb), "i"(d0 * 4096 + ks * 1024 + 512) : "memory"); }
    asm volatile("s_waitcnt lgkmcnt(0)" ::: "memory"); ATT_SBAR();
#define ATT_PK(d, k) (bf16x8){lo[d][k][0], lo[d][k][1], lo[d][k][2], lo[d][k][3], hi[d][k][0], hi[d][k][1], hi[d][k][2], hi[d][k][3]}
    o[0] = __builtin_amdgcn_mfma_f32_32x32x16_bf16(pa0, ATT_PK(0, 0), o[0], 0, 0, 0); o[1] = __builtin_amdgcn_mfma_f32_32x32x16_bf16(pa0, ATT_PK(1, 0), o[1], 0, 0, 0);
    o[0] = __builtin_amdgcn_mfma_f32_32x32x16_bf16(pa1, ATT_PK(0, 1), o[0], 0, 0, 0); o[1] = __builtin_amdgcn_mfma_f32_32x32x16_bf16(pa1, ATT_PK(1, 1), o[1], 0, 0, 0);
    o[0] = __builtin_amdgcn_mfma_f32_32x32x16_bf16(pa2, ATT_PK(0, 2), o[0], 0, 0, 0); o[1] = __builtin_amdgcn_mfma_f32_32x32x16_bf16(pa2, ATT_PK(1, 2), o[1], 0, 0, 0);
    o[0] = __builtin_amdgcn_mfma_f32_32x32x16_bf16(pa3, ATT_PK(0, 3), o[0], 0, 0, 0); o[1] = __builtin_amdgcn_mfma_f32_32x32x16_bf16(pa3, ATT_PK(1, 3), o[1], 0, 0, 0);
#undef ATT_PK
}
template <int DQ, bool SWA>
__device__ __forceinline__ void attn_unit(LAS unsigned char* lds, const bf16* Qw, const int qld, const bf16* Kh, const int kld, const bf16* Kpe, const bf16* Vh, const int vld, bf16* Ow,
                                          const int a0, const int n1, const int n2, const int qpos0, const float mhat0, const float l0) {
    constexpr int NKS = DQ / 16; constexpr float THR = 6.0f;
    int tid_ = threadIdx.x; asm volatile("" : "+v"(tid_));
    const int tid = tid_, lane = tid & 63, r32 = lane & 31, hi = lane >> 5; const int wid = __builtin_amdgcn_readfirstlane(tid >> 6);
    const unsigned lds0 = (unsigned)(uintptr_t)lds;
    LAS float* wsf = (LAS float*)(lds + LWS) + wid * 64;
    const bf16* ksrc0 = Kh + (size_t)lane * kld + wid * 8;
    const bf16* ksrc1 = Kpe + (size_t)lane * 32 + (wid & 3) * 8;
    const bf16* vsrc = Vh + (size_t)(16 * (wid & 3) + (lane >> 2)) * vld + (wid >> 2) * 32 + (lane & 3) * 8;
    const unsigned kdst0 = lds0 + LK + wid * 1024, kdst1 = lds0 + LK + (8 + (wid & 3)) * 1024, vdst = lds0 + LV + wid * 1024;
    const int NT = n1 + n2;
#define ATT_TILE(i) ((i) < n1 ? a0 + (i) : 64 + (i) - n1)
#define ATT_DMA(i) do { const size_t ko_ = (size_t)ATT_TILE(i) * 64; const int s_ = (i) & 3; glds16(ksrc0 + ko_ * kld, (unsigned)__builtin_amdgcn_readfirstlane(kdst0 + s_ * KSLOT)); \
        if (DQ == 96) glds16(ksrc1 + ko_ * 32, (unsigned)__builtin_amdgcn_readfirstlane(kdst1 + s_ * KSLOT)); \
        glds16(vsrc + ko_ * vld, (unsigned)__builtin_amdgcn_readfirstlane(vdst + s_ * VSLOT)); } while (0)
#define ATT_WAIT_BAR(N) asm volatile("s_waitcnt vmcnt(" #N ") lgkmcnt(0)\n\ts_barrier" ::: "memory")
#define ATT_QK(P0, P1, i) do { const lds_cptr kp_ = kp0 + ((i) & 3) * KSLOT; P0 = f32x16{}; P1 = f32x16{}; \
        _Pragma("unroll") for (int d0 = 0; d0 < NKS; ++d0) { const bf16x8 b0_ = *(const LAS bf16x8*)(kp_ + d0 * 2048), b1_ = *(const LAS bf16x8*)(kp_ + d0 * 2048 + 512); \
            P0 = __builtin_amdgcn_mfma_f32_32x32x16_bf16(b0_, qr[d0], P0, 0, 0, 0); P1 = __builtin_amdgcn_mfma_f32_32x32x16_bf16(b1_, qr[d0], P1, 0, 0, 0); } } while (0)
    bf16x8 qr[NKS];
#pragma unroll
    for (int d0 = 0; d0 < NKS; ++d0) qr[d0] = *(const bf16x8*)(Qw + (size_t)r32 * qld + d0 * 16 + hi * 8);
    if (wid >= 4) __builtin_amdgcn_s_setprio(1);
    ATT_DMA(0); ATT_DMA(1); ATT_DMA(2);
    float mhat = mhat0, l_reg = (hi == 0) ? l0 : 0.f; f32x16 o[2]; o[0] = f32x16{}; o[1] = f32x16{};
    const int vb0 = (int)(lds0 + LV) + ((lane >> 4) & 1) * 32 + (lane & 3) * 8 + (4 * hi + ((lane & 15) >> 2)) * 64;
    const lds_cptr kp0 = (lds_cptr)(lds + LK) + hi * 1024 + r32 * 16;
    const int qpos = qpos0 + wid * 32 + r32;
    const int qw0 = qpos0 + wid * 32;
#define ATT_MASK(P0, P1, i) do { if (SWA && (i) < n1 && (64 * (a0 + (i)) - qw0 > 159 || 64 * (a0 + (i)) - qw0 < -191)) { _Pragma("unroll") for (int r = 0; r < 16; ++r) { P0[r] = -1e30f; P1[r] = -1e30f; } }     \
        else if (SWA && (i) < n1 && (64 * (a0 + (i)) - qw0 < -97 || 64 * (a0 + (i)) - qw0 > 65)) { const int kb_ = 64 * (a0 + (i)) + 4 * hi - qpos; \
        _Pragma("unroll") for (int r = 0; r < 16; ++r) { const int rel_ = kb_ + (r & 3) + 8 * (r >> 2); P0[r] = (rel_ > 128 || rel_ < -128) ? -1e30f : P0[r]; P1[r] = (rel_ + 32 > 128 || rel_ + 32 < -128) ? -1e30f : P1[r]; } } } while (0)
#define ATT_RESCALE(rm_) do { if (__any((rm_) > mhat + THR)) { const float mn_ = fmaxf(mhat, (rm_)), f_ = __builtin_amdgcn_exp2f(mhat - mn_); l_reg *= f_; mhat = mn_; \
        if (hi == 0) wsf[r32] = f_; asm volatile("s_waitcnt lgkmcnt(0)" ::: "memory"); \
        _Pragma("unroll") for (int d = 0; d < 2; ++d) _Pragma("unroll") for (int r = 0; r < 16; ++r) o[d][r] *= wsf[crow(r, hi)]; \
        asm volatile("s_waitcnt lgkmcnt(0)" ::: "memory"); } } while (0)
#define ATT_RESCALE_N(rp_, N0_, N1_) do { if (__any((rp_) > THR)) { const float d_ = fmaxf((rp_), 0.f), f_ = __builtin_amdgcn_exp2f(-d_); l_reg *= f_; \
        if (hi == 0) wsf[r32] = f_; asm volatile("s_waitcnt lgkmcnt(0)" ::: "memory"); \
        _Pragma("unroll") for (int d = 0; d < 2; ++d) _Pragma("unroll") for (int r = 0; r < 16; ++r) o[d][r] *= wsf[crow(r, hi)]; \
        _Pragma("unroll") for (int r = 0; r < 16; ++r) { N0_[r] -= d_; N1_[r] -= d_; negm[r] -= d_; } \
        asm volatile("s_waitcnt lgkmcnt(0)" ::: "memory"); } } while (0)
    f32x16 p0, p1, n0, n1v, negm;
    if (DQ == 96) ATT_WAIT_BAR(6); else ATT_WAIT_BAR(4);
    ATT_QK(p0, p1, 0); ATT_MASK(p0, p1, 0);
    { const float rm0 = rowmax(p0, p1); ATT_RESCALE(rm0); }
#pragma unroll
    for (int r = 0; r < 16; ++r) { p0[r] -= mhat; p1[r] -= mhat; negm[r] = -mhat; }
    constexpr int CB6[7] = {0, 4, 8, 12, 16, 20, 24}, CB4[5] = {0, 6, 12, 18, 24};
    auto step = [&](f32x16& P0, f32x16& P1, f32x16& N0, f32x16& N1, const int it) __attribute__((always_inline)) {
        if (it + 2 < NT) { if (DQ == 96) ATT_WAIT_BAR(3); else ATT_WAIT_BAR(2); } else ATT_WAIT_BAR(0);
        if (it + 3 < NT) ATT_DMA(it + 3);
        bf16x8 kf[2 * NKS];
        { const lds_cptr kp_ = kp0 + ((it + 1) & 3) * KSLOT;
#pragma unroll
          for (int d0 = 0; d0 < NKS; ++d0) { kf[2 * d0] = *(const LAS bf16x8*)(kp_ + d0 * 2048); kf[2 * d0 + 1] = *(const LAS bf16x8*)(kp_ + d0 * 2048 + 512); } }
        f32x2 sacc = {0.f, 0.f};
        ATT_SBAR();
#pragma unroll
        for (int d0 = 0; d0 < NKS; ++d0) {
            N0 = __builtin_amdgcn_mfma_f32_32x32x16_bf16(kf[2 * d0], qr[d0], d0 ? N0 : negm, 0, 0, 0); N1 = __builtin_amdgcn_mfma_f32_32x32x16_bf16(kf[2 * d0 + 1], qr[d0], d0 ? N1 : negm, 0, 0, 0);
            const int lo_ = (NKS == 6) ? CB6[d0] : CB4[d0], hi_ = (NKS == 6) ? CB6[d0 + 1] : CB4[d0 + 1];
#pragma unroll
            for (int i = 0; i < 32; i += 2) if (i >= lo_ && i < hi_) { if (i < 16) { P0[i] = __builtin_amdgcn_exp2f(P0[i]); P0[i + 1] = __builtin_amdgcn_exp2f(P0[i + 1]); sacc += (f32x2){P0[i], P0[i + 1]}; }
                else { P1[i - 16] = __builtin_amdgcn_exp2f(P1[i - 16]); P1[i - 15] = __builtin_amdgcn_exp2f(P1[i - 15]); sacc += (f32x2){P1[i - 16], P1[i - 15]}; } }
            ATT_SBAR();
        }
        const u32x4 pw0 = {cvtpk(P0[0], P0[1]), cvtpk(P0[2], P0[3]), cvtpk(P0[4], P0[5]), cvtpk(P0[6], P0[7])}, pw1 = {cvtpk(P0[8], P0[9]), cvtpk(P0[10], P0[11]), cvtpk(P0[12], P0[13]), cvtpk(P0[14], P0[15])};
        const u32x4 pw2 = {cvtpk(P1[0], P1[1]), cvtpk(P1[2], P1[3]), cvtpk(P1[4], P1[5]), cvtpk(P1[6], P1[7])};
        { const int vb = vb0 + (it & 3) * VSLOT; s16x4 vlo[2][4], vhi[2][4];
#pragma unroll
          for (int d0 = 0; d0 < 2; ++d0)
#pragma unroll
              for (int ks = 0; ks < 4; ++ks) {
                  asm volatile("ds_read_b64_tr_b16 %0,%1 offset:%c2" : "=&v"(vlo[d0][ks]) : "v"(vb), "i"(d0 * 4096 + ks * 1024) : "memory");
                  asm volatile("ds_read_b64_tr_b16 %0,%1 offset:%c2" : "=&v"(vhi[d0][ks]) : "v"(vb), "i"(d0 * 4096 + ks * 1024 + 512) : "memory"); }
          asm volatile("s_waitcnt lgkmcnt(0)" ::: "memory"); ATT_SBAR();
#define ATT_VF(d, k) (bf16x8){vlo[d][k][0], vlo[d][k][1], vlo[d][k][2], vlo[d][k][3], vhi[d][k][0], vhi[d][k][1], vhi[d][k][2], vhi[d][k][3]}
          o[0] = __builtin_amdgcn_mfma_f32_32x32x16_bf16(__builtin_bit_cast(bf16x8, pw0), ATT_VF(0, 0), o[0], 0, 0, 0); o[1] = __builtin_amdgcn_mfma_f32_32x32x16_bf16(__builtin_bit_cast(bf16x8, pw0), ATT_VF(1, 0), o[1], 0, 0, 0);
#pragma unroll
          for (int i = 8; i < 12; i += 2) { P1[i] = __builtin_amdgcn_exp2f(P1[i]); P1[i + 1] = __builtin_amdgcn_exp2f(P1[i + 1]); sacc += (f32x2){P1[i], P1[i + 1]}; }
          ATT_MASK(N0, N1, it + 1); ATT_SBAR();
          o[0] = __builtin_amdgcn_mfma_f32_32x32x16_bf16(__builtin_bit_cast(bf16x8, pw1), ATT_VF(0, 1), o[0], 0, 0, 0); o[1] = __builtin_amdgcn_mfma_f32_32x32x16_bf16(__builtin_bit_cast(bf16x8, pw1), ATT_VF(1, 1), o[1], 0, 0, 0);
#pragma unroll
          for (int i = 12; i < 16; i += 2) { P1[i] = __builtin_amdgcn_exp2f(P1[i]); P1[i + 1] = __builtin_amdgcn_exp2f(P1[i + 1]); sacc += (f32x2){P1[i], P1[i + 1]}; }
          const u32x4 pw3 = {cvtpk(P1[8], P1[9]), cvtpk(P1[10], P1[11]), cvtpk(P1[12], P1[13]), cvtpk(P1[14], P1[15])};
          l_reg += sacc[0] + sacc[1];
          ATT_SBAR();
          o[0] = __builtin_amdgcn_mfma_f32_32x32x16_bf16(__builtin_bit_cast(bf16x8, pw2), ATT_VF(0, 2), o[0], 0, 0, 0); o[1] = __builtin_amdgcn_mfma_f32_32x32x16_bf16(__builtin_bit_cast(bf16x8, pw2), ATT_VF(1, 2), o[1], 0, 0, 0);
          float ra = vmax3(N0[0], N1[0], N0[1]);
#pragma unroll
          for (int r = 1; r < 8; ++r) ra = vmax3(ra, N1[r], N0[r < 7 ? r + 1 : r]);
          ATT_SBAR();
          o[0] = __builtin_amdgcn_mfma_f32_32x32x16_bf16(__builtin_bit_cast(bf16x8, pw3), ATT_VF(0, 3), o[0], 0, 0, 0); o[1] = __builtin_amdgcn_mfma_f32_32x32x16_bf16(__builtin_bit_cast(bf16x8, pw3), ATT_VF(1, 3), o[1], 0, 0, 0);
#pragma unroll
          for (int r = 8; r < 16; ++r) ra = vmax3(ra, N0[r], N1[r]);
#undef ATT_VF
          auto rr = __builtin_amdgcn_permlane32_swap(__float_as_uint(ra), __float_as_uint(ra), false, false); const float rm = fmaxf(__uint_as_float(rr[0]), __uint_as_float(rr[1]));
          ATT_SBAR();
          if (it + 1 < NT) ATT_RESCALE_N(rm, N0, N1); }
    };
    for (int it = 0; it < NT; it += 2) { step(p0, p1, n0, n1v, it); if (it + 1 < NT) step(n0, n1v, p0, p1, it + 1); }
#undef ATT_MASK
#undef ATT_RESCALE
#undef ATT_RESCALE_N
    { auto rr = __builtin_amdgcn_permlane32_swap(__float_as_uint(l_reg), __float_as_uint(l_reg), false, false); l_reg = __uint_as_float(rr[0]) + __uint_as_float(rr[1]); }
    if (hi == 0) wsf[32 + r32] = l_reg;
    asm volatile("s_waitcnt lgkmcnt(0)" ::: "memory");
    float rli[16];
#pragma unroll
    for (int r = 0; r < 16; ++r) rli[r] = __builtin_amdgcn_rcpf(wsf[32 + crow(r, hi)]);
    { LAS bf16* stg = (LAS bf16*)(lds + LOST) + wid * 2048;
#pragma unroll
      for (int r = 0; r < 16; ++r) { const int orow = crow(r, hi);
#pragma unroll
          for (int d0 = 0; d0 < 2; ++d0) stg[orow * 64 + d0 * 32 + r32] = (bf16)(cvtpk(o[d0][r] * rli[r], 0.f) & 0xffffu); }
      asm volatile("s_waitcnt lgkmcnt(0)" ::: "memory");
#pragma unroll
      for (int i = 0; i < 4; ++i) { const int row = i * 8 + (lane >> 3), ch = lane & 7; const u32x4 v = *(const LAS u32x4*)(stg + row * 64 + ch * 8); *(u32x4*)(Ow + (size_t)row * D + ch * 8) = v; } }
    __builtin_amdgcn_s_setprio(0);
    asm volatile("s_waitcnt lgkmcnt(0)\n\ts_barrier" ::: "memory");
#undef ATT_TILE
#undef ATT_DMA
#undef ATT_WAIT_BAR
#undef ATT_QK
}
#undef ATT_SBAR
}

__device__ __forceinline__ void row_load(const float* src, int lane, f32x4 (&v)[8]) {
#pragma unroll
    for (int j = 0; j < 8; ++j) v[j] = *(const f32x4*)(src + 4 * lane + 256 * j);
}
__device__ __forceinline__ void row_load_bf(const bf16* src, int lane, f32x4 (&v)[8]) {
#pragma unroll
    for (int j = 0; j < 8; ++j) { const u32x2 w = *(const u32x2*)(src + 4 * lane + 256 * j); v[j] = (f32x4){bf_lo(w.x), bf_hi(w.x), bf_lo(w.y), bf_hi(w.y)}; }
}
__device__ __forceinline__ float row_ssq(const f32x4 (&v)[8]) {
    float s = 0.f;
#pragma unroll
    for (int j = 0; j < 8; ++j) s += (v[j][0] * v[j][0] + v[j][1] * v[j][1]) + (v[j][2] * v[j][2] + v[j][3] * v[j][3]);
    return wave_sum(s);
}
__device__ __forceinline__ void row_norm_mod(f32x4 (&v)[8], int lane, const float* g, const float* sh, const float* sc, bf16* dst) {
    const float rstd = rsqrtf(row_ssq(v) * (1.0f / D) + EPS);
#pragma unroll
    for (int j = 0; j < 8; ++j) { const int c = 4 * lane + 256 * j; const f32x4 gg = *(const f32x4*)(g + c), s1 = *(const f32x4*)(sc + c), s0 = *(const f32x4*)(sh + c);
        v[j] = v[j] * rstd * gg * (s1 + 1.0f) + s0; *(u32x2*)(dst + c) = pack4(v[j]); }
}

template <class RowMap>
__device__ __forceinline__ void transpose_item(const float* W, int N, const float* gk, bf16* WT, int ldk, int kdst0, LAS float* scr, int kb, int nb, int lane, const RowMap& rmap) {
    const int k0 = 64 * kb, n0 = 32 * nb;
    float wv[32];
    { const float* src = W + (size_t)(k0 + (lane >> 5)) * N + n0 + (lane & 31);
#pragma unroll
      for (int i = 0; i < 32; ++i) wv[i] = src[(size_t)(2 * i) * N]; }
    if (gk) { const float* gs = gk + k0 + (lane >> 5);
#pragma unroll
      for (int i = 0; i < 32; ++i) wv[i] *= gs[2 * i]; }
#pragma unroll
    for (int i = 0; i < 32; ++i) scr[(2 * i + (lane >> 5)) * 33 + (lane & 31)] = wv[i];
    asm volatile("s_waitcnt lgkmcnt(0)" ::: "memory");
    const int c = lane & 7;
#pragma unroll
    for (int j = 0; j < 4; ++j) { const int n = (lane >> 3) + 8 * j; const LAS float* s = scr + (8 * c) * 33 + n;
        u32x4 o; o.x = cvtpk(s[0 * 33], s[1 * 33]); o.y = cvtpk(s[2 * 33], s[3 * 33]); o.z = cvtpk(s[4 * 33], s[5 * 33]); o.w = cvtpk(s[6 * 33], s[7 * 33]);
        *(u32x4*)(WT + (size_t)rmap(n0 + n) * ldk + kdst0 + k0 + 8 * c) = o; }
    asm volatile("s_waitcnt lgkmcnt(0)" ::: "memory");
}
struct MapInMain { __device__ __forceinline__ int operator()(int s) const {
    if (s < 1536) return s;
    if (s < 2176) { const int q = s - 1536, head = q >> 6, i = q & 63, sh = i >> 5, ii = i & 31; return 1536 + head * 64 + 8 * (ii >> 2) + 4 * sh + (ii & 3); }
    if (s < 2304) return s;
    if (s < 3328) return s - 512;
    if (s < 3584) return s - 512;
    { const int i = s - 3584, sh = i >> 4, ii = i & 15; return 3072 + 8 * (ii >> 2) + 4 * sh + (ii & 3); } } };
struct MapUq { __device__ __forceinline__ int operator()(int s) const { const int head = s / 96, w = s - head * 96; if (w < 64) return s; const int i = w - 64, sh = i >> 4, ii = i & 15; return head * 96 + 64 + 8 * (ii >> 2) + 4 * sh + (ii & 3); } };
struct MapOff { int off; __device__ __forceinline__ int operator()(int s) const { return off + s; } };
struct MapGU { int off; __device__ __forceinline__ int operator()(int s) const { return ((s >> 7) << 8) + off + (s & 127); } };
#ifndef PROBE_DUP
#define PROBE_DUP 0
#endif
__device__ __forceinline__ int wave_isum(int v) {
    v += __builtin_amdgcn_update_dpp(0, v, 0xB1, 0xF, 0xF, true); v += __builtin_amdgcn_update_dpp(0, v, 0x4E, 0xF, 0xF, true);
    v += __builtin_amdgcn_update_dpp(0, v, 0x141, 0xF, 0xF, true); v += __builtin_amdgcn_update_dpp(0, v, 0x140, 0xF, 0xF, true);
    v += __shfl_xor(v, 16); v += __shfl_xor(v, 32);
    return v;
}
__device__ __forceinline__ int block_isum(int v, LAS int* red, int slot, int wave, int lane) {
    const int w = wave_isum(v);
    if (lane == 0) red[slot * 8 + wave] = w;
    __syncthreads();
    int s = 0;
#pragma unroll
    for (int i = 0; i < 8; ++i) s += red[slot * 8 + i];
    return s;
}
__device__ __forceinline__ void block_isum2(int& a, int& b, LAS int* red, int slot, int wave, int lane) {
    const int wa = wave_isum(a), wb = wave_isum(b);
    if (lane == 0) { red[512 + slot * 16 + wave] = wa; red[512 + slot * 16 + 8 + wave] = wb; }
    __syncthreads();
    int sa = 0, sb = 0;
#pragma unroll
    for (int i = 0; i < 8; ++i) { sa += red[512 + slot * 16 + i]; sb += red[512 + slot * 16 + 8 + i]; }
    a = sa; b = sb;
}
__device__ __forceinline__ int block_exscan(int v, LAS int* red, int slot, int wave, int lane) {
    int inc = v;
#pragma unroll
    for (int o = 1; o < 64; o <<= 1) { const int y = __shfl_up(inc, o); if (lane >= o) inc += y; }
    if (lane == 63) red[slot * 8 + wave] = inc;
    __syncthreads();
    int base = 0;
#pragma unroll
    for (int i = 0; i < 8; ++i) base += (i < wave) ? red[slot * 8 + i] : 0;
    return base + inc - v;
}

__device__ __forceinline__ void topk_task(LAS int* red, int set, int e, const float* AFF, int* TOK, int* POS) {
    const int tid = threadIdx.x, lane = tid & 63, wave = tid >> 6;
    const bool lat = set < 4; const int N = lat ? SEQ : CTXL, cap = lat ? CAPL : CAPC, tok0 = lat ? set * SEQ : TL + (set - 4) * CTXL;
    const int rowbase = e * EROWS + (lat ? set * CAPL : NB * CAPL + (set - 4) * CAPC);
    unsigned u[8];
#pragma unroll
    for (int i = 0; i < 8; ++i) { const int idx = tid * 8 + i; u[i] = idx < N ? __float_as_uint(AFF[(size_t)(tok0 + idx) * 16 + e]) + 1u : 0u; }
    unsigned lo = 1u, hi = 0x7f800002u; int it = 0;
    while (hi - lo > 1u) { const unsigned dd = hi - lo, m2 = lo + (dd >> 1), m1 = lo + (dd >> 2), m3 = m2 + ((hi - m2) >> 1); int c12 = 0, c3 = 0;
#pragma unroll
        for (int i = 0; i < 8; ++i) { c12 += ((u[i] >= m1) ? 1 : 0) + ((u[i] >= m2) ? 65536 : 0); c3 += (u[i] >= m3) ? 1 : 0; }
        block_isum2(c12, c3, red, it & 1, wave, lane); ++it;
        const int n1 = c12 & 0xffff, n2 = c12 >> 16;
        if (c3 >= cap) lo = m3; else if (n2 >= cap) { lo = m2; hi = m3; } else if (n1 >= cap) { lo = m1; hi = m2; } else hi = m1; }
    it = 0;
    const unsigned Tv = lo; int ngt = 0, neq = 0;
#pragma unroll
    for (int i = 0; i < 8; ++i) { ngt += (u[i] > Tv) ? 1 : 0; neq += (u[i] == Tv) ? 1 : 0; }
    const int cgt = block_isum(ngt, red, it & 1, wave, lane); ++it;
    const int need = cap - cgt;
    int eqb = block_exscan(neq, red, it & 1, wave, lane); ++it;
    int nsel = 0; bool sel[8];
#pragma unroll
    for (int i = 0; i < 8; ++i) { sel[i] = (u[i] > Tv) || (u[i] == Tv && eqb < need); if (u[i] == Tv) ++eqb; nsel += sel[i] ? 1 : 0; }
    int slot = block_exscan(nsel, red, it & 1, wave, lane); ++it;
#pragma unroll
    for (int i = 0; i < 8; ++i) { const int idx = tid * 8 + i; if (idx < N) { int p = -1; if (sel[i]) { p = rowbase + slot; ++slot; TOK[p] = tok0 + idx; } POS[(size_t)(tok0 + idx) * 16 + e] = p; } }
    __syncthreads();
}

struct Args { const float* in[22]; float* out; unsigned char* ws; };
enum { I_X = 0, I_C, I_CTX, I_CCTX, I_ADAW, I_ADAB, I_N1G, I_N2G, I_WIN, I_CONVW, I_SINK, I_QNG, I_WUQ, I_KVNG, I_WUKV, I_ONG, I_WOUT, I_WR, I_WG, I_WU, I_WD, I_FNG };

constexpr int MOE_PER_LAYER = 3 * NE * 2048, MOE_SLACK_ITEMS = MOE_PER_LAYER;
constexpr int MOE_P0_SHARE_L = MOE_PER_LAYER - MOE_SLACK_ITEMS;
struct MoeIt { const float* src; bf16* dst; int which; };
__device__ __forceinline__ MoeIt moe_item(unsigned char* ws, LAS unsigned char* lds, int g, int lane) {
    const int l = g / (3 * NE * 2048); int r = g - l * (3 * NE * 2048); const int which = r / (NE * 2048); r -= which * (NE * 2048); const int e = r >> 11; r &= 2047; const int kb = r >> 6, nb = r & 63;
    const float* base = which == 0 ? IN(I_WG) : which == 1 ? IN(I_WU) : IN(I_WD);
    MoeIt m; m.which = which;
    m.src = base + ((size_t)(l * NE + e) * D + 64 * kb + (lane >> 3)) * FF + 32 * nb + 4 * (lane & 7);
    bf16* d = which < 2 ? (bf16*)(ws + WS_WGU) + (size_t)(l * NE + e) * 2 * FF * D : (bf16*)(ws + WS_WD) + (size_t)(l * NE + e) * D * FF;
    const int c = lane & 7, n = 32 * nb + (lane >> 3);
    const int row = which < 2 ? ((n >> 7) << 8) + which * 128 + (n & 127) : n;
    m.dst = d + (size_t)row * D + 64 * kb + 8 * c; return m;
}
constexpr int MOE_SLOT = 8 * 1040, MOE_WAVE_LDS = 2 * MOE_SLOT;
__device__ __forceinline__ void moe_dma(const MoeIt& m, unsigned slot_lds, int lane) {
    const float* s = m.src;
#pragma unroll
    for (int i = 0; i < 8; ++i) att::glds16(s + (size_t)(8 * i) * FF, (unsigned)__builtin_amdgcn_readfirstlane(slot_lds + i * 1040));
}
template <bool STORE = true> __device__ __forceinline__ void moe_finish(const MoeIt& m, LAS const float* slot, int lane) {
    const int c = lane & 7;
#pragma unroll
    for (int j = 0; j < 4; ++j) { const int n = (lane >> 3) + 8 * j; const LAS float* s = slot + c * 260 + n;
        u32x4 o; o.x = cvtpk(s[0], s[32]); o.y = cvtpk(s[64], s[96]); o.z = cvtpk(s[128], s[160]); o.w = cvtpk(s[192], s[224]);
        if (STORE) *(u32x4*)(m.dst + (size_t)(8 * j) * D) = o; else asm volatile("" :: "v"(o)); }
}
template <bool STORE = true> __device__ __forceinline__ void moe_convert(unsigned char* ws, LAS unsigned char* lds, int first, int stride, int end, int wave, int lane) {
    LAS unsigned char* base = lds + wave * MOE_WAVE_LDS; const unsigned b0 = (unsigned)(uintptr_t)base;
    int g = first; if (g >= end) return;
    MoeIt ma = moe_item(ws, lds, g, lane), mb = ma; moe_dma(ma, b0, lane);
    { int gn = g + stride;
      if (gn < end) { mb = moe_item(ws, lds, gn, lane); moe_dma(mb, b0 + MOE_SLOT, lane); asm volatile("s_waitcnt vmcnt(8)" ::: "memory"); } else asm volatile("s_waitcnt vmcnt(0)" ::: "memory");
      moe_finish<STORE>(ma, (LAS const float*)base, lane); asm volatile("s_waitcnt lgkmcnt(0)" ::: "memory");
      if (gn >= end) { asm volatile("s_waitcnt vmcnt(0)" ::: "memory"); return; } g = gn; }
    for (;;) {
        int gn = g + stride;
        if (gn < end) { ma = moe_item(ws, lds, gn, lane); moe_dma(ma, b0, lane); asm volatile("s_waitcnt vmcnt(12)" ::: "memory"); } else asm volatile("s_waitcnt vmcnt(0)" ::: "memory");
        moe_finish<STORE>(mb, (LAS const float*)(base + MOE_SLOT), lane); asm volatile("s_waitcnt lgkmcnt(0)" ::: "memory");
        if (gn >= end) break; g = gn;
        gn = g + stride;
        if (gn < end) { mb = moe_item(ws, lds, gn, lane); moe_dma(mb, b0 + MOE_SLOT, lane); asm volatile("s_waitcnt vmcnt(12)" ::: "memory"); } else asm volatile("s_waitcnt vmcnt(0)" ::: "memory");
        moe_finish<STORE>(ma, (LAS const float*)base, lane); asm volatile("s_waitcnt lgkmcnt(0)" ::: "memory");
        if (gn >= end) break; g = gn;
    }
    asm volatile("s_waitcnt vmcnt(0)" ::: "memory");
}

__device__ __forceinline__ float bf_el(const u32x4& w, int e) { const unsigned x = w[e >> 1]; return (e & 1) ? bf_hi(x) : bf_lo(x); }
__device__ __forceinline__ float fnet_fold_row(const bf16* a, const bf16* b, const float sgn, bf16* o, int lane) {
    float nyq = 0.f;
#pragma unroll
    for (int i = 0; i < 4; ++i) { const int k0 = 8 * (lane + 64 * i);
#pragma unroll
        for (int part = 0; part < 2; ++part) { const bf16* src = part ? b : a; const float sg = part ? -1.0f : 1.0f, sc = part ? sgn : 1.0f;
            float v[8];
            if (src) { const u32x4 fw = *(const u32x4*)(src + k0), rv = *(const u32x4*)(src + SEQ - k0 - 8);
                float e0 = 0.f; if (k0 > 0) e0 = __uint_as_float((unsigned)src[SEQ - k0] << 16);
                v[0] = (bf_el(fw, 0) + sg * e0) * sc;
#pragma unroll
                for (int q = 1; q < 8; ++q) v[q] = (bf_el(fw, q) + sg * bf_el(rv, 8 - q)) * sc; }
            else {
#pragma unroll
                for (int q = 0; q < 8; ++q) v[q] = 0.f; }
            if (part == 1 && k0 == 0) v[0] = __uint_as_float((unsigned)a[SEQ / 2] << 16);
            const u32x4 ov = {cvtpk(v[0], v[1]), cvtpk(v[2], v[3]), cvtpk(v[4], v[5]), cvtpk(v[6], v[7])};
            *(u32x4*)(o + part * (SEQ / 2) + k0) = ov;
            if (part == 0) nyq += (bf_lo(ov.x) - bf_hi(ov.x)) + (bf_lo(ov.y) - bf_hi(ov.y)) + (bf_lo(ov.z) - bf_hi(ov.z)) + (bf_lo(ov.w) - bf_hi(ov.w)); else if (k0 == 0) nyq += bf_lo(ov.x); } }
    return nyq;
}

__device__ __forceinline__ void p0_prologue(unsigned char* ws, LAS unsigned char* lds, int gw, int NGW, int wave, int lane_) {
    LAS float* scr = (LAS float*)(lds + wave * MOE_WAVE_LDS);
    constexpr int A1 = 32 * 97, A2 = 8 * 24, A3 = 4 * 32, A4 = 32 * 64, PERL = A1 + A2 + A3 + A4;
    constexpr int NZ = 224 + 768 + 1024, NFOLD = 256, NADA = 2 * 48 * ADA_KC;
    int lane = lane_;
#define P0_SPLIT() asm volatile("" : "+v"(lane))
#define P0REP(k) for (int prep_ = 0; prep_ < ((PROBE_DUP == (k)) ? 2 : 1); ++prep_)
    for (int l = 0; l < 2; ++l) moe_convert(ws, lds, l * MOE_PER_LAYER + MOE_SLACK_ITEMS + gw, NGW, (l + 1) * MOE_PER_LAYER, wave, lane);
    __syncthreads();
    P0_SPLIT();
    P0REP(31) for (int it = gw; it < NADA; it += NGW) {
        int r = it; const int l = r / (48 * ADA_KC); r -= l * (48 * ADA_KC); const int jg = r / ADA_KC, kc = r - jg * ADA_KC, k0 = kc * (D / ADA_KC);
        const float* W = IN(I_ADAW) + (size_t)l * D * 6 * D + jg * 256 + lane * 4; const float* cin = IN(I_C); const float* ccin = IN(I_CCTX);
        f32x4 acc[5];
#pragma unroll
        for (int q = 0; q < 5; ++q) acc[q] = (f32x4){0.f, 0.f, 0.f, 0.f};
        for (int sub = 0; sub < D / ADA_KC / 64; ++sub) { float sv[5];
#pragma unroll
            for (int q = 0; q < 5; ++q) { const float cv = q < 4 ? cin[q * D + k0 + sub * 64 + lane] : ccin[k0 + sub * 64 + lane]; sv[q] = silu_f(cv); }
#pragma unroll 8
            for (int kk = 0; kk < 64; ++kk) { const f32x4 w4 = *(const f32x4*)(W + (size_t)(k0 + sub * 64 + kk) * 6 * D);
#pragma unroll
                for (int q = 0; q < 5; ++q) acc[q] += w4 * __shfl(sv[q], kk); } }
        float* MP = (float*)(ws + WS_MODP) + ((size_t)kc * 2 + l) * 5 * 6 * D + jg * 256 + lane * 4;
#pragma unroll
        for (int q = 0; q < 5; ++q) *(f32x4*)(MP + q * 6 * D) = acc[q];
    }
    P0_SPLIT();
    P0REP(32) for (int it = NGW - 1 - gw; it < 2 * NFOLD; it += NGW) {
        int r = it; const int l = r / NFOLD; r -= l * NFOLD; const int kb = r >> 3, g = r & 7, k0 = 64 * kb;
        const float* W = IN(I_WIN) + (size_t)l * D * INC + 2304 + g * 64;
        float w[64];
#pragma unroll
        for (int i = 0; i < 64; ++i) w[i] = W[(size_t)(k0 + i) * INC + lane];
#pragma unroll
        for (int i = 0; i < 64; ++i) scr[i * 64 + (lane ^ i)] = w[i];
        asm volatile("s_waitcnt lgkmcnt(0)" ::: "memory");
#pragma unroll
        for (int c = 0; c < 64; ++c) w[c] = scr[lane * 64 + (c ^ lane)];
        float tc, tsn; sincospif((float)lane * (1.0f / 32.0f), &tsn, &tc); tc *= 0.125f; tsn *= 0.125f;
        bf16* WF = (bf16*)(ws + WS_WIN) + ((size_t)l * (NIN_MAIN + NIN_F) + NIN_MAIN) * D;
        for (int cp = 0; cp <= 32; ++cp) { float ac = 0.f, as = 0.f;
#pragma unroll
            for (int c = 0; c < 64; ++c) { const int idx = (c * cp) & 63;
                ac += w[c] * __builtin_bit_cast(float, __builtin_amdgcn_readlane(__builtin_bit_cast(int, tc), idx)); as += w[c] * __builtin_bit_cast(float, __builtin_amdgcn_readlane(__builtin_bit_cast(int, tsn), idx)); }
            WF[(size_t)(g * 64 + cp) * D + k0 + lane] = (bf16)(cvtpk(ac, 0.f) & 0xffffu); if (cp >= 1 && cp <= 31) WF[(size_t)(g * 64 + 32 + cp) * D + k0 + lane] = (bf16)(cvtpk(as, 0.f) & 0xffffu); }
        asm volatile("s_waitcnt lgkmcnt(0)" ::: "memory");
    }
    P0_SPLIT();
    P0REP(33) for (int n = gw; n < SEQ / 2; n += NGW) {
        bf16* row = (bf16*)(ws + WS_DN) + (size_t)n * SEQ;
        for (int j = 0; j < 4; ++j) { const int m0 = (j * 64 + lane) * 8; float c[8], s[8];
#pragma unroll
            for (int q = 0; q < 8; ++q) { const float rv = (float)((n * (m0 + q)) & (SEQ - 1)) * (1.0f / 4096.0f); c[q] = __builtin_amdgcn_cosf(rv) * (1.0f / 64.0f); s[q] = __builtin_amdgcn_sinf(rv) * (-1.0f / 64.0f); }
            if (m0 == 0) s[0] = (n & 1) ? (-1.0f / 64.0f) : (1.0f / 64.0f);
            u32x4 oc = {cvtpk(c[0], c[1]), cvtpk(c[2], c[3]), cvtpk(c[4], c[5]), cvtpk(c[6], c[7])}, os = {cvtpk(s[0], s[1]), cvtpk(s[2], s[3]), cvtpk(s[4], s[5]), cvtpk(s[6], s[7])};
            *(u32x4*)(row + m0) = oc; *(u32x4*)(row + SEQ / 2 + m0) = os; }
    }
    P0_SPLIT();
    P0REP(34) for (int it = gw; it < 2 * PERL; it += NGW) {
        const int l = it / PERL; int r = it - l * PERL;
        bf16* WIN = (bf16*)(ws + WS_WIN) + (size_t)l * (NIN_MAIN + NIN_F) * D; bf16* WUP = (bf16*)(ws + WS_WUP) + (size_t)l * NUP * KUP;
        if (r < A1) { const int kb = r / 97; int nb = r - kb * 97; if (nb >= 72) nb += 16; transpose_item(IN(I_WIN) + (size_t)l * D * INC, INC, nullptr, WIN, D, 0, scr, kb, nb, lane, MapInMain{}); continue; } r -= A1;
        if (r < A2) { transpose_item(IN(I_WUQ) + (size_t)l * 512 * 768, 768, IN(I_QNG) + l * 512, WUP, 512, 0, scr, r / 24, r % 24, lane, MapUq{}); continue; } r -= A2;
        if (r < A3) { transpose_item(IN(I_WUKV) + (size_t)l * 256 * 1024, 1024, IN(I_KVNG) + l * 256, WUP + 768 * 512, 256, 0, scr, r / 32, r % 32, lane, MapOff{0}); continue; } r -= A3;
        transpose_item(IN(I_WOUT) + (size_t)l * D * D, D, IN(I_ONG) + l * D, (bf16*)(ws + WS_WO) + (size_t)l * D * D, D, 0, scr, r / 64, r % 64, lane, MapOff{0});
    }
    P0_SPLIT();
    for (int it = gw; it < 2 * NZ; it += NGW) {
        int r = it; const int l = r / NZ; r -= l * NZ;
        bf16* WIN = (bf16*)(ws + WS_WIN) + (size_t)l * (NIN_MAIN + NIN_F) * D; bf16* WUP = (bf16*)(ws + WS_WUP) + (size_t)l * NUP * KUP;
        const u32x4 z = {0u, 0u, 0u, 0u};
        if (r < 224) { u32x4* p = (u32x4*)(WIN + (size_t)(3104 + r) * D);
#pragma unroll
            for (int j = 0; j < 4; ++j) p[lane + 64 * j] = z; }
        (void)WUP;
    }
    P0_SPLIT();
    for (int n = gw; n < SEQ; n += NGW) {
        const int prow = n >> 6, pcol = n & 63;
        if (lane < 48) { const bool sw = lane < 32; const int i = sw ? lane : lane - 32, nf = sw ? 16 : 8; const int j = i < nf ? i : i - nf; const float pos = i < nf ? (float)prow : (float)pcol;
            const float ang = pos * powf(10000.0f, -(float)j / (float)nf); f32x2 cs = {cosf(ang), sinf(ang)};
            if (sw) ((f32x2*)(ws + WS_ROPS))[n * 32 + i] = cs; else ((f32x2*)(ws + WS_ROPM))[n * 16 + i] = cs; }
    }
    P0_SPLIT();
    for (int k = gw; k < CTXL; k += NGW) { bf16* rowl = (bf16*)(ws + WS_DL) + (size_t)k * 2 * CTXL; const int m0 = lane * 8; float cv[8];
#pragma unroll
        for (int q = 0; q < 8; ++q) { const int m = m0 + q, rr = (k * (m & 255)) & 255; float s, cc; sincospif((float)rr * (1.0f / 128.0f), &s, &cc); cv[q] = (m < 256 ? cc : -s) * (1.0f / 16.0f); }
        u32x4 ov = {cvtpk(cv[0], cv[1]), cvtpk(cv[2], cv[3]), cvtpk(cv[4], cv[5]), cvtpk(cv[6], cv[7])}; *(u32x4*)(rowl + m0) = ov; }
#undef P0_SPLIT
#undef P0REP
}
#ifndef PROBE_DUP
#define PROBE_DUP 0
#endif
#ifndef MIX_S0
#define MIX_S0 3
#endif
#ifndef MOE_C0B
#define MOE_C0B 56
#endif
#ifndef MOE_C0
#define MOE_C0 4
#endif
#define REP(k) for (int rep_ = 0; rep_ < ((PROBE_DUP == (k)) ? 2 : 1); ++rep_)
__global__ void __launch_bounds__(NTHR, 2) mega_fwd(Args args) {
    extern __shared__ __attribute__((aligned(16))) unsigned char lds_raw[];
    LAS unsigned char* lds = (LAS unsigned char*)lds_raw;
    const int tid0 = threadIdx.x, wave = __builtin_amdgcn_readfirstlane(tid0 >> 6);
    int tid = tid0, lane = tid0 & 63;
#define MODL (MOD + (size_t)l * 5 * 6 * D)
#define WINl ((const char*)(ws + WS_WIN) + (size_t)l * (NIN_MAIN + NIN_F) * D * 2)
#define LAUNDER() do { tid = threadIdx.x; asm volatile("" : "+v"(tid)); lane = tid & 63; unsigned long long w_ = (unsigned long long)args.ws; asm volatile("" : "+s"(w_)); ws = (unsigned char*)(GAS unsigned char*)w_; } while (0)
    const int G = gridDim.x, c = blockIdx.x, gw = c * NWAVES + wave, NGW = G * NWAVES;
    volatile LAS unsigned* MISC = (volatile LAS unsigned*)(lds + LDS_MISC);
    if (tid < 64) MISC[tid] = 0u;
    if (tid == 0) { LAS unsigned long long* at = (LAS unsigned long long*)(lds + LDS_ARGS);
#pragma unroll
        for (int i = 0; i < 22; ++i) at[i] = (unsigned long long)args.in[i];
        at[22] = (unsigned long long)args.out; }
    __syncthreads();
    unsigned char* ws = args.ws;
    (void)xcd_barrier_post((unsigned*)(ws + WS_CTL) + CW_BAR, MISC + 8);
#define GRID_BAR() do { XcdBarrier b_; b_.bar = (unsigned*)(args.ws + WS_CTL) + CW_BAR; b_.x = xb_xcc_id(); b_.st = (volatile LAS unsigned*)(lds + LDS_MISC) + 8; xcd_barrier(b_); } while (0)
#define MOD ((const float*)(ws + CTL_MOD))
#define X ((bf16*)(ws + WS_X))
#define H ((bf16*)(ws + WS_H))
#define PC ((bf16*)(ws + WS_PC))
#define SQ ((bf16*)(ws + WS_SQ))
#define KS ((bf16*)(ws + WS_KS))
#define VS ((bf16*)(ws + WS_VS))
#define MCQ ((bf16*)(ws + WS_MCQ))
#define QM ((bf16*)(ws + WS_QM))
#define KM ((bf16*)(ws + WS_KM))
#define VM ((bf16*)(ws + WS_VM))
#define GT ((bf16*)(ws + WS_GT))
#define GTC ((bf16*)(ws + WS_GTC))
#define YMIX ((bf16*)(ws + WS_YMIX))
#define SSQ ((float*)(ws + WS_SSQ))
#define AFF ((float*)(ws + WS_AFF))
#define POS ((int*)(ws + WS_POS))
#define TOK ((int*)(ws + WS_TOK))
#define ACT ((bf16*)(ws + WS_ACT))
#define Y ((bf16*)(ws + WS_Y))
#define ROPS ((const f32x2*)(ws + WS_ROPS))
#define ROPM ((const f32x2*)(ws + WS_ROPM))

    LAUNDER();
    p0_prologue(ws, lds, gw, NGW, wave, lane);
    GRID_BAR();
#if PROBE_DUP == 1
    LAUNDER(); p0_prologue(ws, lds, gw, NGW, wave, lane);
    GRID_BAR();
#endif
#if PROBE_DUP == 20
    for (int q = 0; q < 10; ++q) GRID_BAR();
#endif
#if PROBE_DUP == 18
    LAUNDER(); if ((c & 3) == 0) moe_convert(ws, lds, (c >> 2) * NWAVES + wave, 64 * NWAVES, 64 * NWAVES * 40, wave, lane);
    GRID_BAR();
#endif
#if PROBE_DUP == 19
    LAUNDER(); if ((c & 15) == 0) moe_convert(ws, lds, (c >> 4) * NWAVES + wave, 16 * NWAVES, 16 * NWAVES * 40, wave, lane);
    GRID_BAR();
#endif
    LAUNDER();
    for (int i = c * NTHR + tid; i < 2 * 5 * 6 * D; i += G * NTHR) { const int l = i / (5 * 6 * D), j = i % (6 * D); float s = IN(I_ADAB)[l * 6 * D + j];
#pragma unroll
        for (int kc = 0; kc < ADA_KC; ++kc) s += ((const float*)(ws + WS_MODP))[(size_t)kc * 2 * 5 * 6 * D + i];
        ((float*)(ws + CTL_MOD))[i] = s; }
    GRID_BAR();
    LAUNDER();
    REP(14) for (int t0 = gw; t0 < T; t0 += 2 * NGW) { const int t1 = (t0 + NGW < T) ? t0 + NGW : t0; f32x4 v0[8], v1[8];
        row_load(t0 < TL ? IN(I_X) + (size_t)t0 * D : IN(I_CTX) + (size_t)(t0 - TL) * D, lane, v0); row_load(t1 < TL ? IN(I_X) + (size_t)t1 * D : IN(I_CTX) + (size_t)(t1 - TL) * D, lane, v1);
        const float* m0 = MOD + mod_row(t0) * 6 * D; const float* m1 = MOD + mod_row(t1) * 6 * D;
        row_norm_mod(v0, lane, IN(I_N1G), m0, m0 + D, H + (size_t)t0 * D); row_norm_mod(v1, lane, IN(I_N1G), m1, m1 + D, H + (size_t)t1 * D); }
    GRID_BAR();

    for (int l = 0; l < 2; ++l) {
        const bool last = (l == 1); const int rows = last ? TL : T;
        LAUNDER();
        REP(2) { SchedInproj S{(const char*)H, WINl, WINl + (size_t)NIN_MAIN * D * 2, G, c}; EpiInproj E{ws};
          pg8::gemm_phase<false>(lds, D, D * 2, D * 2, S, E);
        GRID_BAR(); }
        LAUNDER();
        REP(3) { int cq = c; asm volatile("" : "+s"(cq)); const char* wupl = (const char*)(ws + WS_WUP) + (size_t)l * NUP * KUP * 2; EpiUp E{ws};
          { SchedPlain S{(const char*)MCQ, wupl, 68, 3, G, cq, KUP * 2, 512 * 2, 0}; pg8::gemm_phase<false>(lds, 512, KUP * 2, 512 * 2, S, E); }
          { const int cr = (cq + G - (204 % G)) % G;
            SchedPlain S{(const char*)(MCQ + 512), wupl + (size_t)768 * 512 * 2, 68, 4, G, cr, KUP * 2, 256 * 2, 1}; pg8::gemm_phase<false>(lds, 256, KUP * 2, 256 * 2, S, E); }
          LAUNDER();
          for (int task = gw; task < NB * 512; task += NGW) { const int cp = task & 63, cc = cp <= 32 ? cp : 64 - cp; const bf16* ga = GT + (size_t)((task & ~63) + cc) * 2 * SEQ;
              const float ny = wave_sum(fnet_fold_row(ga, (cc & 31) ? ga + SEQ : (const bf16*)nullptr, cp <= 32 ? 1.0f : -1.0f, (bf16*)(ws + WS_GTF) + (size_t)task * SEQ, lane)) * (1.0f / 64.0f);
              if (lane == 0) YMIX[(size_t)((task >> 9) * SEQ + SEQ / 2) * D + 1024 + (task & 511)] = (bf16)(cvtpk(ny, 0.f) & 0xffffu); }
        GRID_BAR(); }
        LAUNDER();
        REP(4) {
        if (!last) { SchedFnetC S{(const char*)(ws + WS_DL), (const char*)GTC, c, G}; EpiFnetC E{YMIX}; pg8::gemm_phase<false>(lds, 2 * CTXL, 2 * CTXL * 2, 2 * CTXL * 2, S, E); }
        REP(11) { SchedFnet S{(const char*)(ws + WS_DN), (const char*)(ws + WS_GTF), c, G}; EpiFnet E{YMIX}; pg8::gemm_phase<false>(lds, SEQ, SEQ * 2, SEQ * 2, S, E); }
        {
            int cx = c; asm volatile("" : "+s"(cx));
            const bool tuned = (G == 256); const int x = cx & 7, li = cx >> 3; const int cls = tuned ? (li < 16 ? 0 : li < 24 ? 1 : 2) : 0;
            const int mbase = l * MOE_PER_LAYER, n0a = 512 * MOE_C0, n0i = n0a + 512 * MOE_C0B, n12 = (MOE_PER_LAYER - n0i) / 2;
            if (tuned && cls == 1) { moe_convert(ws, lds, mbase + n0i + ((x * 8 + li - 16) * NWAVES + wave), 64 * NWAVES, mbase + n0i + n12, wave, lane); __syncthreads(); }
            const int nm = tuned ? 2 : (512 - c + G - 1) / G; const int kb = (li < 16) ? 2 * li : 32 + 2 * (li - 16);
            REP(12) for (int i = 0; i < nm; ++i) { const int k = kb + i; const int id = tuned ? (4 * x + (k >> 4)) * 16 + (k & 15) : c + i * G; if (id >= 512) break;
                const int bh = id >> 4, qb = id & 15, b = bh >> 3, h = bh & 7; const size_t r0 = (size_t)b * SEQ + qb * 256 + wave * 32;
                att::attn_unit<96, false>(lds, QM + r0 * 768 + h * 96, 768, KM + (size_t)b * KVR * 512 + h * 64, 512, (const bf16*)(ws + WS_KPE) + (size_t)b * KVR * 32, VM + (size_t)b * KVR * 512 + h * 64, 512, YMIX + r0 * D + 1536 + h * 64, 0, 64, 4, 0, -1e30f, 0.f);
                if (tuned && i == 0 && li >= 8 && li < 16) { moe_convert(ws, lds, mbase + n0a + ((x * 8 + li - 8) * NWAVES + wave), 64 * NWAVES, mbase + n0i, wave, lane); __syncthreads(); } }
            const int ns = tuned ? (li < 8 ? 1 : li < 16 ? 3 : 2) : (512 - c + G - 1) / G; const int sb = li < 8 ? li : li < 16 ? 8 + 3 * (li - 8) : 32 + 2 * (li - 16);
            REP(13) for (int i = 0; i < ns; ++i) { const int k = sb + i; const int id = tuned ? (4 * x + (k >> 4)) * 16 + (k & 15) : c + i * G; if (id >= 512) break;
                const int bh = id >> 4, qb = id & 15, b = bh >> 3, h = bh & 7; const size_t r0 = (size_t)b * SEQ + qb * 256 + wave * 32;
                const int a0 = (4 * qb - 2) < 0 ? 0 : 4 * qb - 2, a1 = (4 * qb + 6) > 64 ? 64 : 4 * qb + 6;
                att::attn_unit<64, true>(lds, SQ + r0 * 512 + h * 64, 512, KS + (size_t)b * KVR * 128 + (h >> 2) * 64, 128, nullptr, VS + (size_t)b * KVR * 128 + (h >> 2) * 64, 128, YMIX + r0 * D + 512 + h * 64,
                                         a0, a1 - a0, 4, qb * 256, IN(I_SINK)[l * 8 + h] * LOG2E, 1.f); }
            if (!last) {
                const int nc = tuned ? (li < 8 ? 1 : 0) : (64 - c + G - 1) / G;
                REP(23) for (int i = 0; i < nc; ++i) { const int id = tuned ? x * 8 + li : c + i * G; if (id >= 64) break;
                    const int bh = id & 31, b = bh >> 3, h = bh & 7; const size_t r0 = (size_t)TL + b * CTXL + wave * 32;
                    if (id < 32) att::attn_unit<96, false>(lds, QM + r0 * 768 + h * 96, 768, KM + (size_t)b * KVR * 512 + h * 64, 512, (const bf16*)(ws + WS_KPE) + (size_t)b * KVR * 32, VM + (size_t)b * KVR * 512 + h * 64, 512, YMIX + r0 * D + 1536 + h * 64, 0, 0, 4, 0, -1e30f, 0.f);
                    else att::attn_unit<64, false>(lds, SQ + r0 * 512 + h * 64, 512, KS + (size_t)b * KVR * 128 + (h >> 2) * 64, 128, nullptr, VS + (size_t)b * KVR * 128 + (h >> 2) * 64, 128, YMIX + r0 * D + 512 + h * 64,
                                                   0, 0, 4, 0, IN(I_SINK)[l * 8 + h] * LOG2E, 1.f); } }
            LAUNDER();
            if (!tuned) moe_convert(ws, lds, mbase + gw, NGW, mbase + MOE_PER_LAYER, wave, lane);
            else if (cls == 0 && li < 8) moe_convert(ws, lds, mbase + ((x * 8 + li) * NWAVES + wave), 64 * NWAVES, mbase + n0a, wave, lane);
            else if (cls == 2) moe_convert(ws, lds, mbase + n0i + n12 + ((x * 8 + li - 24) * NWAVES + wave), 64 * NWAVES, mbase + MOE_PER_LAYER, wave, lane);
        }
        __syncthreads();
        LAUNDER();
        {
            const float* cw = IN(I_CONVW) + l * 3 * 512;
            const bool cv0 = (G == 256); const int t0c = cv0 ? (((c >> 3) < 16) ? ((c & 7) * 16 + (c >> 3)) * NWAVES + wave : rows) : gw, tsc = cv0 ? 128 * NWAVES : NGW;
            REP(21) for (int t = t0c; t < rows; t += tsc) { int pos, len; if (t < TL) { pos = t & (SEQ - 1); len = SEQ; } else { pos = (t - TL) & (CTXL - 1); len = CTXL; }
                const bf16* pr = PC + (size_t)t * 1536 + 8 * lane; float y[8];
                const u32x4 cb = *(const u32x4*)pr, cc = *(const u32x4*)(pr + 512), ch = *(const u32x4*)(pr + 1024);
                const f32x4 w1a = *(const f32x4*)(cw + 512 + 8 * lane), w1b = *(const f32x4*)(cw + 512 + 8 * lane + 4);
#pragma unroll
                for (int q = 0; q < 4; ++q) { y[2 * q] = bf_lo(cc[q]) * bf_lo(ch[q]) * (q < 2 ? w1a[2 * q] : w1b[2 * q - 4]); y[2 * q + 1] = bf_hi(cc[q]) * bf_hi(ch[q]) * (q < 2 ? w1a[2 * q + 1] : w1b[2 * q - 3]); }
                if (pos > 0) { const u32x4 c2 = *(const u32x4*)(pr - 1536 + 512), h2 = *(const u32x4*)(pr - 1536 + 1024); const f32x4 wa = *(const f32x4*)(cw + 8 * lane), wb = *(const f32x4*)(cw + 8 * lane + 4);
#pragma unroll
                    for (int q = 0; q < 4; ++q) { y[2 * q] += bf_lo(c2[q]) * bf_lo(h2[q]) * (q < 2 ? wa[2 * q] : wb[2 * q - 4]); y[2 * q + 1] += bf_hi(c2[q]) * bf_hi(h2[q]) * (q < 2 ? wa[2 * q + 1] : wb[2 * q - 3]); } }
                if (pos < len - 1) { const u32x4 c2 = *(const u32x4*)(pr + 1536 + 512), h2 = *(const u32x4*)(pr + 1536 + 1024); const f32x4 wa = *(const f32x4*)(cw + 1024 + 8 * lane), wb = *(const f32x4*)(cw + 1024 + 8 * lane + 4);
#pragma unroll
                    for (int q = 0; q < 4; ++q) { y[2 * q] += bf_lo(c2[q]) * bf_lo(h2[q]) * (q < 2 ? wa[2 * q] : wb[2 * q - 4]); y[2 * q + 1] += bf_hi(c2[q]) * bf_hi(h2[q]) * (q < 2 ? wa[2 * q + 1] : wb[2 * q - 3]); } }
                u32x4 o; float ss = 0.f;
#pragma unroll
                for (int q = 0; q < 4; ++q) { y[2 * q] *= bf_lo(cb[q]); y[2 * q + 1] *= bf_hi(cb[q]); ss += y[2 * q] * y[2 * q] + y[2 * q + 1] * y[2 * q + 1]; }
                const float rn = rsqrtf(wave_sum(ss) * (1.0f / 512.0f) + EPS);
#pragma unroll
                for (int q = 0; q < 4; ++q) o[q] = cvtpk(y[2 * q] * rn, y[2 * q + 1] * rn);
                *(u32x4*)(YMIX + (size_t)t * D + 8 * lane) = o; }
        }
        LAUNDER();
        GRID_BAR(); }
        LAUNDER();
        for (int t0 = gw; t0 < rows; t0 += 2 * NGW) { const int t1 = (t0 + NGW < rows) ? t0 + NGW : t0; bf16* y0 = YMIX + (size_t)t0 * D + 8 * lane; bf16* y1 = YMIX + (size_t)t1 * D + 8 * lane;
            u32x4 va[4], vb[4];
#pragma unroll
            for (int g = 1; g < 4; ++g) { va[g] = *(const u32x4*)(y0 + 512 * g); vb[g] = *(const u32x4*)(y1 + 512 * g); }
#pragma unroll
            for (int g = 1; g < 4; ++g) { float fa[8], fb[8]; float sa = 0.f, sb = 0.f;
#pragma unroll
                for (int q = 0; q < 4; ++q) { fa[2 * q] = bf_lo(va[g][q]); fa[2 * q + 1] = bf_hi(va[g][q]); sa += fa[2 * q] * fa[2 * q] + fa[2 * q + 1] * fa[2 * q + 1];
                                              fb[2 * q] = bf_lo(vb[g][q]); fb[2 * q + 1] = bf_hi(vb[g][q]); sb += fb[2 * q] * fb[2 * q] + fb[2 * q + 1] * fb[2 * q + 1]; }
                const float ra = rsqrtf(wave_sum(sa) * (1.0f / 512.0f) + EPS), rb = rsqrtf(wave_sum(sb) * (1.0f / 512.0f) + EPS); u32x4 oa, ob;
#pragma unroll
                for (int q = 0; q < 4; ++q) { oa[q] = cvtpk(fa[2 * q] * ra, fa[2 * q + 1] * ra); ob[q] = cvtpk(fb[2 * q] * rb, fb[2 * q + 1] * rb); }
                *(u32x4*)(y0 + 512 * g) = oa; if (t1 != t0) *(u32x4*)(y1 + 512 * g) = ob; } }
        GRID_BAR();
        LAUNDER();
        for (int rep5 = 0; rep5 < ((PROBE_DUP == 5 && l == 0) ? 2 : 1); ++rep5) { SchedPlain S{(const char*)YMIX, (const char*)(ws + WS_WO) + (size_t)l * D * D * 2, rows / 256, 8, G, c, D * 2, D * 2, 0};
          EpiOut E{IN(I_X), IN(I_CTX), l == 0 ? (const bf16*)nullptr : (const bf16*)X, X, MODL};
          pg8::gemm_phase<false>(lds, D, D * 2, D * 2, S, E);
        GRID_BAR(); }
        LAUNDER();
        REP(6) {
        { LAS float* WT = (LAS float*)lds; const float* wr = IN(I_WR) + (size_t)l * D * 16;
          for (int i = tid; i < D * 4; i += NTHR) { const int k = i >> 2, q = i & 3; const f32x4 w = *(const f32x4*)(wr + k * 16 + q * 4);
              WT[(4 * q + 0) * D + k] = w[0]; WT[(4 * q + 1) * D + k] = w[1]; WT[(4 * q + 2) * D + k] = w[2]; WT[(4 * q + 3) * D + k] = w[3]; }
          __syncthreads();
          for (int t0 = gw; t0 < rows; t0 += 2 * NGW) { const int t1 = (t0 + NGW < rows) ? t0 + NGW : t0; f32x4 v0[8], v1[8];
              row_load_bf(X + (size_t)t0 * D, lane, v0); row_load_bf(X + (size_t)t1 * D, lane, v1);
              const float* m0 = MODL + mod_row(t0) * 6 * D; const float* m1 = MODL + mod_row(t1) * 6 * D;
              row_norm_mod(v0, lane, IN(I_N2G) + l * D, m0 + 3 * D, m0 + 4 * D, H + (size_t)t0 * D); row_norm_mod(v1, lane, IN(I_N2G) + l * D, m1 + 3 * D, m1 + 4 * D, H + (size_t)t1 * D);
              float lg0[16], lg1[16];
#pragma unroll
              for (int e = 0; e < 16; ++e) { float s0 = 0.f, s1 = 0.f;
#pragma unroll
                  for (int j = 0; j < 8; ++j) { const f32x4 w = *(const LAS f32x4*)(WT + e * D + 4 * lane + 256 * j);
                      s0 += (v0[j][0] * w[0] + v0[j][1] * w[1]) + (v0[j][2] * w[2] + v0[j][3] * w[3]); s1 += (v1[j][0] * w[0] + v1[j][1] * w[1]) + (v1[j][2] * w[2] + v1[j][3] * w[3]); }
                  lg0[e] = s0; lg1[e] = s1; asm volatile("" ::: "memory"); }
#define P6_RS(N, OFF) _Pragma("unroll") for (int i = 0; i < (N); ++i) { const bool up = (lane & (OFF)) != 0; \
                  const float sa = up ? lg0[i] : lg0[i + (N)], ka = up ? lg0[i + (N)] : lg0[i], sb = up ? lg1[i] : lg1[i + (N)], kb = up ? lg1[i + (N)] : lg1[i]; \
                  lg0[i] = ka + __shfl_xor(sa, (OFF)); lg1[i] = kb + __shfl_xor(sb, (OFF)); }
              P6_RS(8, 32) P6_RS(4, 16) P6_RS(2, 8) P6_RS(1, 4)
#undef P6_RS
              float l0 = lg0[0], l1 = lg1[0];
              l0 += __shfl_xor(l0, 2); l1 += __shfl_xor(l1, 2); l0 += __shfl_xor(l0, 1); l1 += __shfl_xor(l1, 1);
              float mx0 = l0, mx1 = l1;
#pragma unroll
              for (int o = 4; o < 64; o <<= 1) { mx0 = fmaxf(mx0, __shfl_xor(mx0, o)); mx1 = fmaxf(mx1, __shfl_xor(mx1, o)); }
              const float ex0 = __expf(l0 - mx0), ex1 = __expf(l1 - mx1); float den0 = ex0, den1 = ex1;
#pragma unroll
              for (int o = 4; o < 64; o <<= 1) { den0 += __shfl_xor(den0, o); den1 += __shfl_xor(den1, o); }
              if ((lane & 3) == 0) { AFF[(size_t)t0 * 16 + (lane >> 2)] = ex0 / den0; if (t1 != t0) AFF[(size_t)t1 * 16 + (lane >> 2)] = ex1 / den1; } }
          __syncthreads(); }
        GRID_BAR(); }
        LAUNDER();
        REP(7) {
        { const int ntask = last ? 64 : 128; for (int task = c; task < ntask; task += G) topk_task((LAS int*)lds, task >> 4, task & 15, AFF, TOK, POS); }
        GRID_BAR(); }
        LAUNDER();
        const int npm = last ? 8 : 9;
        REP(8) {
        { LAS int* tokl = (LAS int*)(lds + LDS_TOK);
          SchedMoe S{(const char*)H, (const char*)(ws + WS_WGU) + (size_t)l * NE * 2 * FF * D * 2, npm, 16, G, c, 0, (size_t)2 * FF * D * 2, D * 2, tokl};
          { pg8::Unit u; for (int i = 0; S.next(i, u); ++i) if (tid < 256) tokl[i * 256 + tid] = TOK[u.aux * EROWS + (u.pm < 8 ? u.pm * 256 + tid : 2048 + (tid & 127))]; }
          __syncthreads();
          EpiGU E{ACT}; pg8::gemm_phase<true>(lds, D, D * 2, D * 2, S, E); }
        GRID_BAR(); }
        LAUNDER();
        REP(9) {
        { SchedMoe S{(const char*)ACT, (const char*)(ws + WS_WD) + (size_t)l * NE * D * FF * 2, npm, 8, G, c, (size_t)EROWS * FF * 2, (size_t)D * FF * 2, FF * 2, nullptr};
          EpiDown E{Y}; pg8::gemm_phase<false>(lds, FF, FF * 2, FF * 2, S, E); }
        GRID_BAR(); }
        LAUNDER();
        REP(15) for (int t0 = gw; t0 < rows; t0 += 2 * NGW) { const int t1 = (t0 + NGW < rows) ? t0 + NGW : t0; const bool two = (t1 != t0);
            bf16* Xw = X; bf16* Hw = H; float* Ow = (float*)IN(22); if (PROBE_DUP == 15 && rep_ == 0) { Xw = (bf16*)(ws + WS_ACT); Hw = (bf16*)(ws + WS_PC); Ow = (float*)(ws + WS_ACT); }
            f32x4 v0[8], v1[8], s0[8], s1[8]; row_load_bf(X + (size_t)t0 * D, lane, v0); row_load_bf(X + (size_t)t1 * D, lane, v1);
            const int pl0 = (lane < 16) ? POS[(size_t)t0 * 16 + lane] : -1, pl1 = (lane < 16) ? POS[(size_t)t1 * 16 + lane] : -1;
            const float al0 = (lane < 16) ? AFF[(size_t)t0 * 16 + lane] : 0.f, al1 = (lane < 16) ? AFF[(size_t)t1 * 16 + lane] : 0.f;
#pragma unroll
            for (int j = 0; j < 8; ++j) { s0[j] = (f32x4){0.f, 0.f, 0.f, 0.f}; s1[j] = (f32x4){0.f, 0.f, 0.f, 0.f}; }
            unsigned long long sel0 = __ballot(pl0 >= 0), sel1 = __ballot(pl1 >= 0);
            while (sel0 != 0ull && sel1 != 0ull) {
                const int e0 = __builtin_ctzll(sel0), e1 = __builtin_ctzll(sel1); sel0 &= sel0 - 1; sel1 &= sel1 - 1;
                const int p0 = __builtin_amdgcn_readlane(pl0, e0), p1 = __builtin_amdgcn_readlane(pl1, e1);
                const float a0 = __builtin_bit_cast(float, __builtin_amdgcn_readlane(__builtin_bit_cast(int, al0), e0)), a1 = __builtin_bit_cast(float, __builtin_amdgcn_readlane(__builtin_bit_cast(int, al1), e1));
                const bf16* y0 = Y + (size_t)p0 * D + 4 * lane; const bf16* y1 = Y + (size_t)p1 * D + 4 * lane; u32x2 w0[8], w1[8];
#pragma unroll
                for (int j = 0; j < 8; ++j) { w0[j] = *(const u32x2*)(y0 + 256 * j); w1[j] = *(const u32x2*)(y1 + 256 * j); }
#pragma unroll
                for (int j = 0; j < 8; ++j) { s0[j] += (f32x4){bf_lo(w0[j].x), bf_hi(w0[j].x), bf_lo(w0[j].y), bf_hi(w0[j].y)} * a0; s1[j] += (f32x4){bf_lo(w1[j].x), bf_hi(w1[j].x), bf_lo(w1[j].y), bf_hi(w1[j].y)} * a1; } }
            while (sel0 != 0ull) {
                const int e0 = __builtin_ctzll(sel0); sel0 &= sel0 - 1; const int p0 = __builtin_amdgcn_readlane(pl0, e0); const float a0 = __builtin_bit_cast(float, __builtin_amdgcn_readlane(__builtin_bit_cast(int, al0), e0));
                const bf16* y0 = Y + (size_t)p0 * D + 4 * lane; u32x2 w0[8];
#pragma unroll
                for (int j = 0; j < 8; ++j) w0[j] = *(const u32x2*)(y0 + 256 * j);
#pragma unroll
                for (int j = 0; j < 8; ++j) s0[j] += (f32x4){bf_lo(w0[j].x), bf_hi(w0[j].x), bf_lo(w0[j].y), bf_hi(w0[j].y)} * a0; }
            while (sel1 != 0ull) {
                const int e1 = __builtin_ctzll(sel1); sel1 &= sel1 - 1; const int p1 = __builtin_amdgcn_readlane(pl1, e1); const float a1 = __builtin_bit_cast(float, __builtin_amdgcn_readlane(__builtin_bit_cast(int, al1), e1));
                const bf16* y1 = Y + (size_t)p1 * D + 4 * lane; u32x2 w1[8];
#pragma unroll
                for (int j = 0; j < 8; ++j) w1[j] = *(const u32x2*)(y1 + 256 * j);
#pragma unroll
                for (int j = 0; j < 8; ++j) s1[j] += (f32x4){bf_lo(w1[j].x), bf_hi(w1[j].x), bf_lo(w1[j].y), bf_hi(w1[j].y)} * a1; }
            const float* g20 = MODL + mod_row(t0) * 6 * D + 5 * D; const float* g21 = MODL + mod_row(t1) * 6 * D + 5 * D;
#pragma unroll
            for (int j = 0; j < 8; ++j) { v0[j] += *(const f32x4*)(g20 + 4 * lane + 256 * j) * s0[j]; v1[j] += *(const f32x4*)(g21 + 4 * lane + 256 * j) * s1[j]; }
            if (!last) {
#pragma unroll
                for (int j = 0; j < 8; ++j) { *(u32x2*)(Xw + (size_t)t0 * D + 4 * lane + 256 * j) = pack4(v0[j]); if (two) *(u32x2*)(Xw + (size_t)t1 * D + 4 * lane + 256 * j) = pack4(v1[j]); }
                const float* m0 = MOD + (size_t)(l + 1) * 5 * 6 * D + mod_row(t0) * 6 * D; const float* m1 = MOD + (size_t)(l + 1) * 5 * 6 * D + mod_row(t1) * 6 * D;
                row_norm_mod(v0, lane, IN(I_N1G) + (l + 1) * D, m0, m0 + D, Hw + (size_t)t0 * D); row_norm_mod(v1, lane, IN(I_N1G) + (l + 1) * D, m1, m1 + D, Hw + (size_t)t1 * D);
            } else { const float r0 = rsqrtf(row_ssq(v0) * (1.0f / D) + EPS), r1 = rsqrtf(row_ssq(v1) * (1.0f / D) + EPS); float* od = Ow;
#pragma unroll
                for (int j = 0; j < 8; ++j) { const f32x4 fg = *(const f32x4*)(IN(I_FNG) + 4 * lane + 256 * j); *(f32x4*)(od + (size_t)t0 * D + 4 * lane + 256 * j) = v0[j] * r0 * fg; if (two) *(f32x4*)(od + (size_t)t1 * D + 4 * lane + 256 * j) = v1[j] * r1 * fg; } }
        }
        if (!last) GRID_BAR();
    }
}

extern "C" void kernel_launch(void* const* d_in, const int* in_sizes, int n_in, void* d_out, int out_size, void* d_ws, size_t ws_size, hipStream_t stream) {
    static int grid = 0;
    if (grid == 0) {
        if (n_in != 22 || out_size != TL * D || ws_size < WS_END) { fprintf(stderr, "kernel_launch: unexpected problem (n_in %d, out %d, ws %zu < %zu)\n", n_in, out_size, ws_size, (size_t)WS_END); grid = -1; return; }
        int dev = 0, cus = 0, per_cu = 0;
        if (hipGetDevice(&dev) != hipSuccess || hipDeviceGetAttribute(&cus, hipDeviceAttributeMultiprocessorCount, dev) != hipSuccess) { grid = -1; return; }
        if (hipFuncSetAttribute((const void*)mega_fwd, hipFuncAttributeMaxDynamicSharedMemorySize, LDS_BYTES) != hipSuccess) { fprintf(stderr, "kernel_launch: hipFuncSetAttribute failed\n"); grid = -1; return; }
        if (hipOccupancyMaxActiveBlocksPerMultiprocessor(&per_cu, (const void*)mega_fwd, NTHR, LDS_BYTES) != hipSuccess || per_cu < 1) { fprintf(stderr, "kernel_launch: occupancy query reports %d\n", per_cu); (void)hipGetLastError(); grid = -1; return; }
        if (cus < 144) { fprintf(stderr, "kernel_launch: %d CUs: this kernel needs at least 144\n", cus); grid = -1; return; }
        grid = cus;
    }
    if (grid < 0) return;
    if (hipMemsetAsync((char*)d_ws + WS_CTL + (size_t)CW_BAR * 4, 0, (size_t)XCD_BAR_WORDS * 4, stream) != hipSuccess) return;
    Args a{};
    for (int i = 0; i < 22; ++i) a.in[i] = (const float*)d_in[i];
    a.out = (float*)d_out; a.ws = (unsigned char*)d_ws;
    hipLaunchKernelGGL(mega_fwd, dim3(grid), dim3(NTHR), LDS_BYTES, stream, a);
}
```
